# Optimizing an MI355X kernel written in HIP

```python
import jax, jax.numpy as jnp
from jax import lax
import numpy as np

D_MODEL = 2048
BATCH = 2
SEQ = 4096
DEPTH = 2
DEC_BATCH = 32
DEC_SEQ = 1
PAST_LEN = 16384
PAGE_SIZE = 128

D_MIX = D_MODEL
M_WIDTH = D_MIX // 2
M_HEADS = 4
M_DK = M_WIDTH // M_HEADS
M_CHUNK = 128
C_WIDTH = D_MIX // 4
CONV_K = 31
CONV_BUF = CONV_K - 1
A_WIDTH = D_MIX - M_WIDTH - C_WIDTH
HEAD_DIM = 64
A_HEADS = A_WIDTH // HEAD_DIM
KV_HEADS = 2
GROUP = A_HEADS // KV_HEADS
WINDOW = 128
A_BLOCK = WINDOW
ALPHA = (2 * DEPTH) ** 0.25
BETA = (8 * DEPTH) ** -0.25
LN_EPS = 1e-5
IN_SPLITS = (M_WIDTH, M_WIDTH, M_WIDTH, M_WIDTH, M_HEADS, M_HEADS, M_WIDTH,
             C_WIDTH, C_WIDTH, C_WIDTH,
             A_WIDTH, KV_HEADS * HEAD_DIM, KV_HEADS * HEAD_DIM, A_WIDTH)
D_IN = sum(IN_SPLITS)

kernel_name = 'hymba_mlstm_conformer_swa_decode_step'


def layer_norm(x, g, b):
    xf = x.astype(jnp.float32)
    mu = jnp.mean(xf, axis=-1, keepdims=True)
    var = jnp.mean(jnp.square(xf - mu), axis=-1, keepdims=True)
    y = (xf - mu) * lax.rsqrt(var + LN_EPS) * g.astype(jnp.float32) + b.astype(jnp.float32)
    return y.astype(x.dtype)


def in_projection(x, w_in):
    h = jnp.einsum('btd,de->bte', x, w_in)
    cuts = np.cumsum(np.array(IN_SPLITS))[:-1].tolist()
    return jnp.split(h, cuts, axis=-1)


def mlstm_chunk(q, k, v, ig, lf, C0, n0, m0):
    L = q.shape[2]
    b = jnp.cumsum(lf, axis=-1)
    log_w = b[..., :, None] - b[..., None, :] + ig[..., None, :]
    causal = jnp.tril(jnp.ones((L, L), dtype=bool))
    log_w = jnp.where(causal, log_w, -jnp.inf)
    log_w0 = b + m0[..., None]
    m = jnp.maximum(log_w0, jnp.max(log_w, axis=-1))
    w = jnp.exp(log_w - m[..., None])
    w0 = jnp.exp(log_w0 - m)
    s = jnp.einsum('bhtd,bhsd->bhts', q, k) * w
    num = jnp.einsum('bhts,bhse->bhte', s, v) + w0[..., None] * jnp.einsum('bhtd,bhde->bhte', q, C0)
    den = jnp.sum(s, axis=-1) + w0 * jnp.einsum('bhtd,bhd->bht', q, n0)
    h = num / jnp.maximum(jnp.abs(den), jnp.exp(-m))[..., None]
    m_end = m[..., -1]
    g = jnp.exp(b[..., -1:] - b + ig - m_end[..., None])
    g0 = jnp.exp(b[..., -1] + m0 - m_end)
    C = g0[..., None, None] * C0 + jnp.einsum('bhs,bhsd,bhse->bhde', g, k, v)
    n = g0[..., None] * n0 + jnp.einsum('bhs,bhsd->bhd', g, k)
    return h, C, n, m_end


def mlstm_prompt(q, k, v, ig, lf):
    B, T, H, D = q.shape
    nc = T // M_CHUNK

    def to_chunks(a):
        a = a.reshape((B, nc, M_CHUNK) + a.shape[2:])
        return jnp.moveaxis(jnp.moveaxis(a, 1, 0), 2, 3)

    def step(carry, xs):
        h, C, n, m = mlstm_chunk(*xs, *carry)
        return (C, n, m), h

    init = (jnp.zeros((B, H, D, D), jnp.float32), jnp.zeros((B, H, D), jnp.float32),
            jnp.zeros((B, H), jnp.float32))
    (C, n, m), h = lax.scan(step, init, tuple(to_chunks(a) for a in (q, k, v, ig, lf)))
    h = jnp.swapaxes(jnp.moveaxis(h, 0, 1), 2, 3).reshape(B, T, H, D)
    return h, C, n, m


def mlstm_step(q, k, v, ig, lf, C0, n0, m0):
    f32 = jnp.float32
    h, C, n, m = mlstm_chunk(jnp.swapaxes(q, 1, 2), jnp.swapaxes(k, 1, 2), jnp.swapaxes(v, 1, 2),
                             jnp.swapaxes(ig, 1, 2), jnp.swapaxes(lf, 1, 2),
                             C0.astype(f32), n0.astype(f32), m0.astype(f32))
    return jnp.swapaxes(h, 1, 2), C, n, m


def conformer_conv(u, g, buf, conv_w, conv_b, ln_g, ln_b):
    a = u * jax.nn.sigmoid(g)
    a_full = jnp.concatenate([buf.astype(a.dtype), a], axis=1)
    y = lax.conv_general_dilated(a_full, conv_w.astype(a.dtype)[:, None, :], window_strides=(1,),
                                 padding='VALID', dimension_numbers=('NWC', 'WIO', 'NWC'),
                                 feature_group_count=C_WIDTH)
    y = layer_norm(y + conv_b, ln_g, ln_b)
    return jax.nn.silu(y), a_full[:, a_full.shape[1] - CONV_BUF:]


def sink_softmax(scores, mask, sinks):
    scores = jnp.where(mask, scores, -jnp.inf)
    sink = jnp.broadcast_to(sinks.astype(jnp.float32).reshape(KV_HEADS, GROUP, 1, 1),
                            scores.shape[:-1] + (1,))
    probs = jax.nn.softmax(jnp.concatenate([scores, sink], axis=-1), axis=-1)
    return probs[..., :-1]


def swa_prompt(q, k, v, sinks):
    B, T = q.shape[:2]
    nb = T // A_BLOCK
    qb = q.reshape(B, nb, A_BLOCK, KV_HEADS, GROUP, HEAD_DIM)

    def with_prev(a):
        a = a.reshape(B, nb, A_BLOCK, KV_HEADS, HEAD_DIM)
        prev = jnp.concatenate([jnp.zeros_like(a[:, :1]), a[:, :-1]], axis=1)
        return jnp.concatenate([prev, a], axis=2)

    kk, vv = with_prev(k), with_prev(v)
    s = jnp.einsum('bnikgd,bnjkd->bnkgij', qb, kk, preferred_element_type=jnp.float32) * (HEAD_DIM ** -0.5)
    i = jnp.arange(A_BLOCK)[:, None]
    j = jnp.arange(2 * A_BLOCK)[None, :]
    rel = A_BLOCK + i - j
    band = (rel >= 0) & (rel <= WINDOW)
    has_prev = jnp.arange(nb)[:, None, None] > 0
    mask = band[None] & (has_prev | (j >= A_BLOCK)[None])
    p = sink_softmax(s, mask[None, :, None, None], sinks)
    o = jnp.einsum('bnkgij,bnjkd->bnikgd', p.astype(v.dtype), vv).reshape(B, T, A_WIDTH)
    return o, k[:, T - WINDOW:], v[:, T - WINDOW:]


def swa_sample(q, k, v, ck, cv, sinks):
    B, S = q.shape[:2]
    n_buf = ck.shape[1]
    kk = jnp.concatenate([ck.astype(k.dtype), k], axis=1)
    vv = jnp.concatenate([cv.astype(v.dtype), v], axis=1)
    qg = q.reshape(B, S, KV_HEADS, GROUP, HEAD_DIM)
    s = jnp.einsum('bikgd,bjkd->bkgij', qg, kk, preferred_element_type=jnp.float32) * (HEAD_DIM ** -0.5)
    i = jnp.arange(S)[:, None]
    j = jnp.arange(n_buf + S)[None, :]
    rel = n_buf + i - j
    mask = (rel >= 0) & (rel <= WINDOW)
    p = sink_softmax(s, mask, sinks)
    o = jnp.einsum('bkgij,bjkd->bikgd', p.astype(v.dtype), vv).reshape(B, S, A_WIDTH)
    return o, kk[:, S:], vv[:, S:]


def mixer_layer(x, w_in, w_out, b_igate, b_fgate, m_norm_g, conv_w, conv_b, conv_ln_g, conv_ln_b,
                sinks, past):
    B, T, _ = x.shape
    f32 = jnp.float32
    mq, mk, mv, mo, mi, mf, mz, cu, cg, cz, aq, ak, av, az = in_projection(x, w_in)
    q = mq.reshape(B, T, M_HEADS, M_DK).astype(f32)
    k = mk.reshape(B, T, M_HEADS, M_DK).astype(f32) * (M_DK ** -0.5)
    v = mv.reshape(B, T, M_HEADS, M_DK).astype(f32)
    ig = mi.astype(f32) + b_igate.astype(f32)
    lf = jax.nn.log_sigmoid(mf.astype(f32) + b_fgate.astype(f32))
    qa = aq.reshape(B, T, A_HEADS, HEAD_DIM)
    ka = ak.reshape(B, T, KV_HEADS, HEAD_DIM)
    va = av.reshape(B, T, KV_HEADS, HEAD_DIM)
    if past is None:
        h, C, n, m = mlstm_prompt(q, k, v, ig, lf)
        conv_buf = jnp.zeros((B, CONV_BUF, C_WIDTH), x.dtype)
        a_out, new_k, new_v = swa_prompt(qa, ka, va, sinks)
    else:
        C0, n0, m0, conv_buf, ck, cv = past
        h, C, n, m = mlstm_step(q, k, v, ig, lf, C0, n0, m0)
        a_out, new_k, new_v = swa_sample(qa, ka, va, ck, cv, sinks)
    mu = jnp.mean(h, axis=-1, keepdims=True)
    var = jnp.mean(jnp.square(h - mu), axis=-1, keepdims=True)
    hn = ((h - mu) * lax.rsqrt(var + LN_EPS)).reshape(B, T, M_WIDTH) * m_norm_g.astype(f32)
    m_out = hn * jax.nn.sigmoid(mo.astype(f32)) * jax.nn.silu(mz.astype(f32))
    c_out, new_buf = conformer_conv(cu, cg, conv_buf, conv_w, conv_b, conv_ln_g, conv_ln_b)
    merged = jnp.concatenate([m_out.astype(x.dtype),
                              (c_out * jax.nn.silu(cz)).astype(x.dtype),
                              (a_out * jax.nn.silu(az)).astype(x.dtype)], axis=-1)
    y = jnp.einsum('bte,ed->btd', merged, w_out)
    return y, (C, n, m, new_buf, new_k, new_v)


def setup_inputs(seed: int = 0) -> dict:
    key = jax.random.key(seed)
    ks = jax.random.split(key, 24)
    nrm = jax.random.normal
    n_buf = min(WINDOW, PAST_LEN)
    return {
        'x_prompt': nrm(ks[0], (BATCH, SEQ, D_MODEL), jnp.float32),
        'x_sample': nrm(ks[1], (DEC_BATCH, DEC_SEQ, D_MODEL), jnp.float32),
        'state_C': 0.5 * nrm(ks[2], (DEPTH, DEC_BATCH, M_HEADS, M_DK, M_DK), jnp.float32),
        'state_n': 0.5 * nrm(ks[3], (DEPTH, DEC_BATCH, M_HEADS, M_DK), jnp.float32),
        'state_m': nrm(ks[4], (DEPTH, DEC_BATCH, M_HEADS), jnp.float32),
        'state_conv': 0.5 * nrm(ks[5], (DEPTH, DEC_BATCH, CONV_BUF, C_WIDTH), jnp.float32),
        'cache_k': nrm(ks[6], (DEPTH, DEC_BATCH, n_buf, KV_HEADS, HEAD_DIM), jnp.float32),
        'cache_v': nrm(ks[7], (DEPTH, DEC_BATCH, n_buf, KV_HEADS, HEAD_DIM), jnp.float32),
        'w_in': nrm(ks[8], (DEPTH, D_MODEL, D_IN), jnp.float32) * (D_MODEL ** -0.5),
        'w_out': nrm(ks[9], (DEPTH, D_MIX, D_MODEL), jnp.float32) * (D_MIX ** -0.5) * BETA,
        'b_igate': 0.1 * nrm(ks[10], (DEPTH, M_HEADS), jnp.float32),
        'b_fgate': 3.0 + 3.0 * jax.random.uniform(ks[11], (DEPTH, M_HEADS), jnp.float32),
        'm_norm_g': 1.0 + 0.1 * nrm(ks[12], (DEPTH, M_WIDTH), jnp.float32),
        'conv_w': nrm(ks[13], (DEPTH, CONV_K, C_WIDTH), jnp.float32) * (CONV_K ** -0.5),
        'conv_b': 0.02 * nrm(ks[14], (DEPTH, C_WIDTH), jnp.float32),
        'conv_ln_g': 1.0 + 0.1 * nrm(ks[15], (DEPTH, C_WIDTH), jnp.float32),
        'conv_ln_b': 0.02 * nrm(ks[16], (DEPTH, C_WIDTH), jnp.float32),
        'sinks': 0.5 * nrm(ks[17], (DEPTH, A_HEADS), jnp.float32),
        'ln_g': 1.0 + 0.1 * nrm(ks[18], (DEPTH, D_MODEL), jnp.float32),
        'ln_b': 0.02 * nrm(ks[19], (DEPTH, D_MODEL), jnp.float32),
    }


def reference(x_prompt, x_sample, state_C, state_n, state_m, state_conv, cache_k, cache_v,
              w_in, w_out, b_igate, b_fgate, m_norm_g, conv_w, conv_b, conv_ln_g, conv_ln_b,
              sinks, ln_g, ln_b):
    xp, xs = x_prompt, x_sample
    new_p = [[] for _ in range(6)]
    new_s = [[] for _ in range(6)]
    for l in range(DEPTH):
        params = (w_in[l], w_out[l], b_igate[l], b_fgate[l], m_norm_g[l], conv_w[l], conv_b[l],
                  conv_ln_g[l], conv_ln_b[l], sinks[l])
        yp, sp = mixer_layer(xp, *params, None)
        ys, ss = mixer_layer(xs, *params, (state_C[l], state_n[l], state_m[l], state_conv[l],
                                           cache_k[l], cache_v[l]))
        xp = layer_norm(ALPHA * xp + yp, ln_g[l], ln_b[l])
        xs = layer_norm(ALPHA * xs + ys, ln_g[l], ln_b[l])
        for lst, a in zip(new_p, sp):
            lst.append(a)
        for lst, a in zip(new_s, ss):
            lst.append(a)
    new_C_p, new_n_p, new_m_p, new_conv_p, new_k_p, new_v_p = [jnp.stack(a, axis=0) for a in new_p]
    new_C_s, new_n_s, new_m_s, new_conv_s, new_k_s, new_v_s = [jnp.stack(a, axis=0) for a in new_s]
    return (xp, xs, new_C_p, new_n_p, new_m_p, new_conv_p, new_k_p, new_v_p,
            new_C_s, new_n_s, new_m_s, new_conv_s, new_k_s, new_v_s)
```

```cpp
#include <hip/hip_runtime.h>
#include <hip/hip_bf16.h>
#include <hip/hip_cooperative_groups.h>
#include <cstdio>
namespace cg = cooperative_groups;

typedef unsigned short u16;
typedef __attribute__((ext_vector_type(8))) short bf16x8;
typedef __attribute__((ext_vector_type(4))) float f32x4;
#define DI __device__ __forceinline__

#ifndef REPEAT_MASK
#define REPEAT_MASK 0
#endif
#ifndef M1_MODE
#define M1_MODE 0
#endif
#ifndef GS2
#define GS2 0
#endif
#ifndef OUT_MASK
#define OUT_MASK 0
#endif
#ifndef PROBE_STAGE
#define PROBE_STAGE 0
#endif
#ifndef PROBE_POISON
#define PROBE_POISON 0
#endif
#ifndef PROBE_AUX
#define PROBE_AUX 0
#endif
#ifndef M3_DBG
#define M3_DBG 0
#endif
#ifndef M3_PCONST
#define M3_PCONST 0
#endif
#ifndef M3_SKIP
#define M3_SKIP 0
#endif
#ifndef SAFE_GEMM
#define SAFE_GEMM 0
#endif
#ifndef STRONG_SYNC
#define STRONG_SYNC 1
#endif
constexpr int LDS_BYTES = 147456;
constexpr int D = 2048, TP = 8192, TT = 8224, MP = 8448, NH = 7936, DIN = 7944;
constexpr int HQ = 0, HK = 1024, HV = 2048, HO = 3072, HZ = 4096, HCU = 5120, HCG = 5632, HCZ = 6144, HAQ = 6656, HAK = 7168, HAV = 7296, HAZ = 7424;
constexpr float ALPHA = 1.41421356237309515f;
constexpr float LN_EPS = 1e-5f;

constexpr size_t O_YP = 0, O_YS = 16777216, O_CP = 16842752, O_NP = 17891328, O_MP = 17895424, O_CONVP = 17895440,
                 O_KP = 17956880, O_VP = 18022416, O_CS = 18087952, O_NS = 34865168, O_MS = 34930704, O_CONVS = 34930960,
                 O_KS = 35914000, O_VS = 36962576;
constexpr size_t WS_XB = 0, WS_WTI = 34603008, WS_WTO = 67108864, WS_H = 83886080, WS_CSB = 217972736, WS_DN = 251527168,
                 WS_AB = 251789312, WS_M0 = 251791360, WS_GIG = 251792384, WS_GLF = 251923968, WS_BAR = 252055552, WS_CS2 = 252056064, WS_N0 = 285610496,
                 WS_STATP = 285872640, WS_GPART = 286396928, WS_GW = 288494080;

struct Args { const float* in[20]; float* out; unsigned char* ws; };
struct Ctx {
    const float *x_prompt, *x_sample, *state_C, *state_n, *state_m, *state_conv, *cache_k, *cache_v, *w_in, *w_out, *b_i, *b_f, *mng,
        *conv_w, *conv_b, *cln_g, *cln_b, *sinks, *ln_g, *ln_b;
    float* out;
    u16 *XB, *WTI, *WTO, *H, *CS, *CS2;
    float *DN, *AB, *M0, *GIG, *GLF, *N0, *STATP, *GPART, *GW;
    unsigned *PANEL, *SAMP, *MCNT, *SCNT, *QCNT;
};

DI int otid() { int t = threadIdx.x; asm volatile("" : "+v"(t)); return t; }
DI u16 f2bf(float x) { unsigned u = __float_as_uint(x); u += 0x7fffu + ((u >> 16) & 1u); return (u16)(u >> 16); }
DI float bf2f(u16 h) { return __uint_as_float(((unsigned)h) << 16); }
DI unsigned pack2(float a, float b) { return (unsigned)f2bf(a) | ((unsigned)f2bf(b) << 16); }
DI float sigm(float x) { return 1.f / (1.f + __expf(-x)); }
DI float silu(float x) { return x / (1.f + __expf(-x)); }
DI float wave_sum(float v) { for (int o = 32; o > 0; o >>= 1) v += __shfl_xor(v, o); return v; }
DI float wave_max(float v) { for (int o = 32; o > 0; o >>= 1) v = fmaxf(v, __shfl_xor(v, o)); return v; }
#define PIN8(x) asm volatile("" : "+v"(x[0]), "+v"(x[1]), "+v"(x[2]), "+v"(x[3]), "+v"(x[4]), "+v"(x[5]), "+v"(x[6]), "+v"(x[7]))
DI f32x4 mfma16(bf16x8 a, bf16x8 b, f32x4 c) { return __builtin_amdgcn_mfma_f32_16x16x32_bf16(a, b, c, 0, 0, 0); }


constexpr int BM = 256, BK = 64, HALF = 128, NXCD = 8, WGM = 8, HT = HALF * BK, GK = 2048;
DI void publish_counter(unsigned* cnt) {
    asm volatile("s_waitcnt vmcnt(0)" ::: "memory");
    __syncthreads();
    if (threadIdx.x == 0) {
        __builtin_amdgcn_fence(__ATOMIC_RELEASE, "agent");
        asm volatile("s_waitcnt vmcnt(0)" ::: "memory");
        (void)__hip_atomic_fetch_add(cnt, 1u, __ATOMIC_RELAXED, __HIP_MEMORY_SCOPE_AGENT);
    }
}
DI void wait_counter(unsigned* cnt, const unsigned target) {
    if (threadIdx.x == 0) {
        unsigned sp = 0;
        while (__hip_atomic_load(cnt, __ATOMIC_RELAXED, __HIP_MEMORY_SCOPE_AGENT) < target) { __builtin_amdgcn_s_sleep(2); if (++sp > (1u << 24)) break; }
        __builtin_amdgcn_fence(__ATOMIC_ACQUIRE, "agent");
        asm volatile("s_waitcnt vmcnt(0)" ::: "memory");
    }
    __syncthreads();
}

DI void st_wt8(void* p, const uint2 v) { __hip_atomic_store((unsigned long long*)p, ((unsigned long long)v.y << 32) | (unsigned long long)v.x, __ATOMIC_RELAXED, __HIP_MEMORY_SCOPE_AGENT); }
DI void st_wt4(float* p, const float v) { __hip_atomic_store(p, v, __ATOMIC_RELAXED, __HIP_MEMORY_SCOPE_AGENT); }
DI uint2 ld_wt8(const void* p) { const unsigned long long v = __hip_atomic_load((const unsigned long long*)p, __ATOMIC_RELAXED, __HIP_MEMORY_SCOPE_AGENT); uint2 r; r.x = (unsigned)v; r.y = (unsigned)(v >> 32); return r; }
DI float ld_wt4(const float* p) { return __hip_atomic_load(p, __ATOMIC_RELAXED, __HIP_MEMORY_SCOPE_AGENT); }
DI void wait_counter_wt(unsigned* cnt, const unsigned target) {
    if (threadIdx.x == 0) { unsigned sp = 0;
        while (__hip_atomic_load(cnt, __ATOMIC_RELAXED, __HIP_MEMORY_SCOPE_AGENT) < target) { __builtin_amdgcn_s_sleep(2); if (++sp > (1u << 24)) break; } }
    __syncthreads();
}
DI void arrive_wait_wt(unsigned* cnt, const unsigned target) {
    asm volatile("s_waitcnt vmcnt(0)" ::: "memory");
    __syncthreads();
    if (threadIdx.x == 0) {
        (void)__hip_atomic_fetch_add(cnt, 1u, __ATOMIC_RELAXED, __HIP_MEMORY_SCOPE_AGENT);
        unsigned sp = 0; while (__hip_atomic_load(cnt, __ATOMIC_RELAXED, __HIP_MEMORY_SCOPE_AGENT) < target) { __builtin_amdgcn_s_sleep(1); if (++sp > (1u << 24)) break; }
    }
    __syncthreads();
}
DI void publish_counter_wt(unsigned* cnt) {
    asm volatile("s_waitcnt vmcnt(0)" ::: "memory");
    __syncthreads();
    if (threadIdx.x == 0) (void)__hip_atomic_fetch_add(cnt, 1u, __ATOMIC_RELAXED, __HIP_MEMORY_SCOPE_AGENT);
}

DI unsigned arrive_counter(unsigned* cnt, const unsigned target, const bool wait) {
    unsigned old = 0;
    asm volatile("s_waitcnt vmcnt(0)" ::: "memory");
    __syncthreads();
    if (threadIdx.x == 0) {
        __builtin_amdgcn_fence(__ATOMIC_RELEASE, "agent");
        asm volatile("s_waitcnt vmcnt(0)" ::: "memory");
        old = __hip_atomic_fetch_add(cnt, 1u, __ATOMIC_RELAXED, __HIP_MEMORY_SCOPE_AGENT);
        if (wait) { unsigned sp = 0; while (__hip_atomic_load(cnt, __ATOMIC_RELAXED, __HIP_MEMORY_SCOPE_AGENT) < target) { __builtin_amdgcn_s_sleep(1); if (++sp > (1u << 24)) break; } }
        __builtin_amdgcn_fence(__ATOMIC_ACQUIRE, "agent");
        asm volatile("s_waitcnt vmcnt(0)" ::: "memory");
    }
    __syncthreads();
    return old;
}

DI void epi_ln(f32x4 (&acc)[2][2][4][2], const Ctx& cx, const int layer, const int brow, const int bcol, const int pm, const int pn, unsigned char* lds) {
    const int et = otid(); const int ewr = et >> 8, ewc = (et >> 6) & 3, efr = et & 15, efq = (et >> 4) & 3;
    float* sred = (float*)lds;
    float* sstat = (float*)(lds + 135168);
    float* sg = (float*)(lds + 16384);
#pragma unroll
    for (int ai = 0; ai < 2; ++ai)
#pragma unroll
      for (int m = 0; m < 4; ++m) {
        const int row = brow + ai * HALF + ewr * 64 + m * 16 + efr;
        const float* rs = (layer == 0) ? cx.x_prompt + (size_t)row * D : cx.out + (size_t)row * D;
        float s = 0.f, q = 0.f;
#pragma unroll
        for (int bj = 0; bj < 2; ++bj)
#pragma unroll
          for (int n = 0; n < 2; ++n) {
            const int col = bcol + bj * HALF + ewc * 32 + n * 16 + efq * 4;
            const float4 xr = *(const float4*)(rs + col);
            f32x4 v = acc[ai][bj][m][n];
            v[0] = ALPHA * xr.x + v[0]; v[1] = ALPHA * xr.y + v[1]; v[2] = ALPHA * xr.z + v[2]; v[3] = ALPHA * xr.w + v[3];
            acc[ai][bj][m][n] = v;
            s += v[0] + v[1] + v[2] + v[3]; q += v[0] * v[0] + v[1] * v[1] + v[2] * v[2] + v[3] * v[3];
          }
        s += __shfl_xor(s, 16); s += __shfl_xor(s, 32); q += __shfl_xor(q, 16); q += __shfl_xor(q, 32);
        if (efq == 0) { const int rt = ai * HALF + ewr * 64 + m * 16 + efr; sred[(ewc * 256 + rt) * 2] = s; sred[(ewc * 256 + rt) * 2 + 1] = q; }
      }
    __syncthreads();
    if (et < 256) { float ps = 0.f, pq = 0.f;
#pragma unroll
        for (int w = 0; w < 4; ++w) { ps += sred[(w * 256 + et) * 2]; pq += sred[(w * 256 + et) * 2 + 1]; }
        uint2 pv; pv.x = __float_as_uint(ps); pv.y = __float_as_uint(pq); st_wt8(cx.STATP + ((size_t)(brow + et) * 8 + pn) * 2, pv); }
    arrive_wait_wt(cx.PANEL + layer * 32 + pm, 8u);
    if (et < 256) { const float* p = cx.STATP + (size_t)(brow + et) * 16;
        uint2 t8[8];
#pragma unroll
        for (int k = 0; k < 8; ++k) t8[k] = ld_wt8(p + k * 2);
        const float ssum = ((__uint_as_float(t8[0].x) + __uint_as_float(t8[1].x)) + (__uint_as_float(t8[2].x) + __uint_as_float(t8[3].x))) + ((__uint_as_float(t8[4].x) + __uint_as_float(t8[5].x)) + (__uint_as_float(t8[6].x) + __uint_as_float(t8[7].x)));
        const float qsum = ((__uint_as_float(t8[0].y) + __uint_as_float(t8[1].y)) + (__uint_as_float(t8[2].y) + __uint_as_float(t8[3].y))) + ((__uint_as_float(t8[4].y) + __uint_as_float(t8[5].y)) + (__uint_as_float(t8[6].y) + __uint_as_float(t8[7].y)));
        const float mu = ssum * (1.f / 2048.f);
        sstat[et * 2] = mu; sstat[et * 2 + 1] = rsqrtf(fmaxf(qsum * (1.f / 2048.f) - mu * mu, 0.f) + LN_EPS); }
    __syncthreads();
    float4 g4[2][2], b4[2][2];
#pragma unroll
    for (int bj = 0; bj < 2; ++bj)
#pragma unroll
      for (int n = 0; n < 2; ++n) { const int col = bcol + bj * HALF + ewc * 32 + n * 16 + efq * 4;
          g4[bj][n] = *(const float4*)(cx.ln_g + layer * D + col); b4[bj][n] = *(const float4*)(cx.ln_b + layer * D + col); }
    float* tf = (float*)lds;
    const int elane = et & 63, ewave = et >> 6;
#pragma unroll
    for (int ai = 0; ai < 2; ++ai) {
#pragma unroll
      for (int m = 0; m < 4; ++m) {
        const int rt = ai * HALF + ewr * 64 + m * 16 + efr; const float mu = sstat[rt * 2], rs_ = sstat[rt * 2 + 1];
#pragma unroll
        for (int bj = 0; bj < 2; ++bj)
#pragma unroll
          for (int n = 0; n < 2; ++n) {
            f32x4 v = acc[ai][bj][m][n];
            v[0] = (v[0] - mu) * rs_ * g4[bj][n].x + b4[bj][n].x; v[1] = (v[1] - mu) * rs_ * g4[bj][n].y + b4[bj][n].y;
            v[2] = (v[2] - mu) * rs_ * g4[bj][n].z + b4[bj][n].z; v[3] = (v[3] - mu) * rs_ * g4[bj][n].w + b4[bj][n].w;
            acc[ai][bj][m][n] = v;
            *(float4*)(tf + (ewr * 64 + m * 16 + efr) * 260 + bj * HALF + ewc * 32 + n * 16 + efq * 4) = make_float4(v[0], v[1], v[2], v[3]);
          }
      }
      __syncthreads();
#pragma unroll 4
      for (int r = 0; r < 16; ++r) { const int rr = ewave * 16 + r; const size_t grow = (size_t)(brow + ai * HALF + rr);
          const float4 v = *(const float4*)(tf + rr * 260 + elane * 4);
          *(float4*)(cx.out + grow * D + bcol + elane * 4) = v;
          if (layer == 0) { uint2 o; o.x = pack2(v.x, v.y); o.y = pack2(v.z, v.w); *(uint2*)(cx.XB + grow * D + bcol + elane * 4) = o; } }
      __syncthreads();
    }
    if (layer == 0) {
#pragma unroll 1
        for (int jg = 0; jg < 8; ++jg) {
            float4 w4[2][2];
#pragma unroll
            for (int bj = 0; bj < 2; ++bj)
#pragma unroll
              for (int n = 0; n < 2; ++n) w4[bj][n] = *(const float4*)(cx.GW + (size_t)(8 + jg) * 2048 + bcol + bj * HALF + ewc * 32 + n * 16 + efq * 4);
#pragma unroll
            for (int ai = 0; ai < 2; ++ai)
#pragma unroll
              for (int m = 0; m < 4; ++m) { float p = 0.f;
#pragma unroll
                for (int bj = 0; bj < 2; ++bj)
#pragma unroll
                  for (int n = 0; n < 2; ++n) { const f32x4 v = acc[ai][bj][m][n]; p += v[0] * w4[bj][n].x + v[1] * w4[bj][n].y + v[2] * w4[bj][n].z + v[3] * w4[bj][n].w; }
                p += __shfl_xor(p, 16); p += __shfl_xor(p, 32);
                if (efq == 0) { const int rt = ai * HALF + ewr * 64 + m * 16 + efr; sg[(ewc * 256 + rt) * 8 + jg] = p; } }
        }
        __syncthreads();
        if (et < 256) { float o8[8];
#pragma unroll
            for (int jg = 0; jg < 8; ++jg) o8[jg] = (sg[(0 * 256 + et) * 8 + jg] + sg[(1 * 256 + et) * 8 + jg]) + (sg[(2 * 256 + et) * 8 + jg] + sg[(3 * 256 + et) * 8 + jg]);
            float4* gp = (float4*)(cx.GPART + ((size_t)(brow + et) * 8 + pn) * 8);
            gp[0] = make_float4(o8[0], o8[1], o8[2], o8[3]); gp[1] = make_float4(o8[4], o8[5], o8[6], o8[7]); }
    }
    __syncthreads();
}

DI void sample_ln(const Ctx& c, const int l) {
    const int tid = otid(), lane = tid & 63, wave = __builtin_amdgcn_readfirstlane(tid >> 6);
    for (int k = 0; k < 4; ++k) {
        const int row = TP + wave * 4 + k;
        float4 v[8];
#pragma unroll
        for (int i = 0; i < 8; ++i) v[i] = *(const float4*)(c.out + (size_t)row * D + i * 256 + lane * 4);
        float s = 0.f;
#pragma unroll
        for (int i = 0; i < 8; ++i) s += v[i].x + v[i].y + v[i].z + v[i].w;
        const float mu = wave_sum(s) * (1.f / 2048.f);
        float q = 0.f;
#pragma unroll
        for (int i = 0; i < 8; ++i) { float a = v[i].x - mu, b = v[i].y - mu, cc = v[i].z - mu, d = v[i].w - mu; q += a * a + b * b + cc * cc + d * d; }
        const float rstd = rsqrtf(wave_sum(q) * (1.f / 2048.f) + LN_EPS);
        float ga[8];
#pragma unroll
        for (int j = 0; j < 8; ++j) ga[j] = 0.f;
#pragma unroll
        for (int i = 0; i < 8; ++i) {
            const float4 gg = *(const float4*)(c.ln_g + l * D + i * 256 + lane * 4), be = *(const float4*)(c.ln_b + l * D + i * 256 + lane * 4);
            v[i].x = (v[i].x - mu) * rstd * gg.x + be.x; v[i].y = (v[i].y - mu) * rstd * gg.y + be.y;
            v[i].z = (v[i].z - mu) * rstd * gg.z + be.z; v[i].w = (v[i].w - mu) * rstd * gg.w + be.w;
            *(float4*)(c.out + (size_t)row * D + i * 256 + lane * 4) = v[i];
            if (l == 0) {
                uint2 o; o.x = pack2(v[i].x, v[i].y); o.y = pack2(v[i].z, v[i].w);
                *(uint2*)(c.XB + (size_t)row * D + i * 256 + lane * 4) = o;
#pragma unroll
                for (int j = 0; j < 8; ++j) { const float4 ww = *(const float4*)(c.GW + (size_t)(8 + j) * 2048 + i * 256 + lane * 4);
                    ga[j] += v[i].x * ww.x + v[i].y * ww.y + v[i].z * ww.z + v[i].w * ww.w; }
            }
        }
        if (l == 0) {
#pragma unroll
            for (int j = 0; j < 8; ++j) ga[j] = wave_sum(ga[j]);
            if (lane < 4) {
                float gi = ga[0], gf = ga[4];
                if (lane == 1) { gi = ga[1]; gf = ga[5]; } else if (lane == 2) { gi = ga[2]; gf = ga[6]; } else if (lane == 3) { gi = ga[3]; gf = ga[7]; }
                c.GIG[row * 4 + lane] = gi + c.b_i[4 + lane];
                const float z = gf + c.b_f[4 + lane];
                c.GLF[row * 4 + lane] = fminf(z, 0.f) - __logf(1.f + __expf(-fabsf(z)));
            }
        }
    }
}

DI int lds_byte(int r, int c) {
    int st = (r >> 4) * 2 + (c >> 5), rr = r & 15, cc = c & 31, ob = rr * 64 + cc * 2;
    return st * 1024 + (ob ^ (((ob >> 9) & 1) << 5));
}
DI void stage_rc(int b, int& R, int& C) {
    int st = b / 1024, sb = b % 1024, swz = sb ^ (((sb >> 9) & 1) << 5);
    R = (st >> 1) * 16 + swz / 64; C = (st & 1) * 32 + (swz % 64) / 2;
}

template <int EPI>
DI void gemm_phase(const u16* __restrict__ A, const u16* __restrict__ Bt, const int nM, const int nN, const Ctx& cx, const int layer, unsigned char* lds) {
    u16* shm = (u16*)lds;
#define SA(b, h) (shm + ((b) * 2 + (h)) * HT)
#define SB(b, h) (shm + (4 + (b) * 2 + (h)) * HT)
#define STAGE(P, BASE, br, kt) do { const char* _gb = (const char*)((BASE) + (long)(br) * GK + (long)(kt) * BK); \
    for (int _i = 0; _i < 2; ++_i) { int _b = gtid * 16 + _i * 8192; unsigned _o = _i ? soff1 : soff0; asm volatile("" : "+v"(_o)); \
      __builtin_amdgcn_global_load_lds((const unsigned*)(_gb + _o), (unsigned*)((char*)(P) + _b), 16, 0, 0); } } while (0)
#define LDA(dst, b, h) for (int m = 0; m < 4; ++m) for (int k = 0; k < 2; ++k) \
    dst[m][k] = *reinterpret_cast<const bf16x8*>((char*)SA(b, h) + lds_byte(wr * 64 + m * 16 + fr, k * 32 + fq * 8))
#define LDB(dst, b, h) for (int n = 0; n < 2; ++n) for (int k = 0; k < 2; ++k) \
    dst[n][k] = *reinterpret_cast<const bf16x8*>((char*)SB(b, h) + lds_byte(wc * 32 + n * 16 + fr, k * 32 + fq * 8))
#define MMA(ai, bj, At, Btt) do { __builtin_amdgcn_s_setprio(1); \
    for (int m = 0; m < 4; ++m) for (int n = 0; n < 2; ++n) for (int k = 0; k < 2; ++k) \
      acc[ai][bj][m][n] = __builtin_amdgcn_mfma_f32_16x16x32_bf16(Btt[n][k], At[m][k], acc[ai][bj][m][n], 0, 0, 0); \
    __builtin_amdgcn_s_setprio(0); } while (0)
#define WAIT_V(n) asm volatile("s_waitcnt vmcnt(" #n ")" ::: "memory")
#define WAIT_L(n) asm volatile("s_waitcnt lgkmcnt(" #n ")" ::: "memory")
#define BAR __builtin_amdgcn_s_barrier()
#define SCHED __builtin_amdgcn_sched_barrier(0)
    const int nwg = nM * nN; const int gtid = otid();
    const int wid = gtid >> 6, lane = gtid & 63, wr = wid >> 2, wc = wid & 3, fr = lane & 15, fq = lane >> 4;
    unsigned soff0, soff1;
    { int r, c2; stage_rc(gtid * 16, r, c2); soff0 = (unsigned)(r * GK + c2) * 2u; stage_rc(gtid * 16 + 8192, r, c2); soff1 = (unsigned)(r * GK + c2) * 2u; }
    constexpr int nt = GK / BK;
    for (int tile = blockIdx.x; tile < nwg; tile += gridDim.x) {
        int wgid = tile;
        { int q = nwg / NXCD, r = nwg % NXCD, xcd = wgid % NXCD, off = wgid / NXCD;
          wgid = (xcd < r ? xcd * (q + 1) : r * (q + 1) + (xcd - r) * q) + off; }
        const int nig = WGM * nN, gid = wgid / nig, fm = gid * WGM, gsz = min(nM - fm, WGM);
        const int pm = fm + ((wgid % nig) % gsz), pn = (wgid % nig) / gsz, brow = pm * BM, bcol = pn * BM;
        f32x4 acc[2][2][4][2];
        for (int a = 0; a < 2; ++a) for (int b = 0; b < 2; ++b) for (int m = 0; m < 4; ++m) for (int n = 0; n < 2; ++n) acc[a][b][m][n] = (f32x4){0.f, 0.f, 0.f, 0.f};
        bf16x8 At[4][2], B0[2][2], B1[2][2];
#if SAFE_GEMM
        for (int t = 0; t < nt; ++t) {
            STAGE(SB(0, 0), Bt, bcol, t); STAGE(SA(0, 0), A, brow, t); STAGE(SB(0, 1), Bt, bcol + HALF, t); STAGE(SA(0, 1), A, brow + HALF, t);
            WAIT_V(0); __syncthreads();
            LDB(B0, 0, 0); LDB(B1, 0, 1); LDA(At, 0, 0); WAIT_L(0);
            MMA(0, 0, At, B0); MMA(0, 1, At, B1);
            LDA(At, 0, 1); WAIT_L(0);
            MMA(1, 0, At, B0); MMA(1, 1, At, B1);
            __syncthreads();
        }
#else
        STAGE(SB(0, 0), Bt, bcol, 0); STAGE(SA(0, 0), A, brow, 0);
        STAGE(SB(0, 1), Bt, bcol + HALF, 0); STAGE(SA(0, 1), A, brow + HALF, 0);
        if (wr == 1) BAR;
        WAIT_V(4); BAR;
        STAGE(SB(1, 0), Bt, bcol, 1); STAGE(SA(1, 0), A, brow, 1); STAGE(SB(1, 1), Bt, bcol + HALF, 1);
        WAIT_V(6); BAR;
        for (int t = 0; t < nt - 2; t += 2) {
            LDB(B0, 0, 0); SCHED; LDA(At, 0, 0); STAGE(SA(1, 1), A, brow + HALF, t + 1);
            WAIT_L(8); BAR; WAIT_L(0); MMA(0, 0, At, B0); BAR; SCHED;
            LDB(B1, 0, 1); STAGE(SB(0, 0), Bt, bcol, t + 2);
            BAR; WAIT_L(0); MMA(0, 1, At, B1); BAR;
            LDA(At, 0, 1); STAGE(SA(0, 0), A, brow, t + 2);
            BAR; WAIT_L(0); MMA(1, 0, At, B0); BAR; SCHED;
            STAGE(SB(0, 1), Bt, bcol + HALF, t + 2);
            WAIT_V(6); BAR; MMA(1, 1, At, B1); BAR;
            LDB(B0, 1, 0); SCHED; LDA(At, 1, 0); STAGE(SA(0, 1), A, brow + HALF, t + 2);
            WAIT_L(8); BAR; WAIT_L(0); MMA(0, 0, At, B0); BAR; SCHED;
            LDB(B1, 1, 1); STAGE(SB(1, 0), Bt, bcol, t + 3);
            BAR; WAIT_L(0); MMA(0, 1, At, B1); BAR;
            LDA(At, 1, 1); STAGE(SA(1, 0), A, brow, t + 3);
            BAR; WAIT_L(0); MMA(1, 0, At, B0); BAR; SCHED;
            STAGE(SB(1, 1), Bt, bcol + HALF, t + 3);
            WAIT_V(6); BAR; MMA(1, 1, At, B1); BAR;
        }
        { LDB(B0, 0, 0); LDA(At, 0, 0); STAGE(SA(1, 1), A, brow + HALF, nt - 1);
          BAR; WAIT_L(0); MMA(0, 0, At, B0); BAR;
          LDB(B1, 0, 1); BAR; WAIT_L(0); MMA(0, 1, At, B1); BAR;
          LDA(At, 0, 1); WAIT_V(4); BAR; WAIT_L(0); MMA(1, 0, At, B0); MMA(1, 1, At, B1); BAR; }
        { LDB(B0, 1, 0); LDA(At, 1, 0); WAIT_V(2); BAR; WAIT_L(0); MMA(0, 0, At, B0); BAR;
          LDB(B1, 1, 1); WAIT_V(0); BAR; WAIT_L(0); MMA(0, 1, At, B1); BAR;
          LDA(At, 1, 1); BAR; WAIT_L(0); MMA(1, 0, At, B0); MMA(1, 1, At, B1); BAR; }
        if (wr == 0) BAR;
#endif
        if (EPI == 2) { epi_ln(acc, cx, layer, brow, bcol, pm, pn, lds); continue; }
        if (EPI == 0) {
            const int et = otid(); const int ewr = et >> 8, ewc = (et >> 6) & 3, efr = et & 15, efq = (et >> 4) & 3, elane = et & 63, ewave = et >> 6;
            u16* tl = (u16*)lds;
#pragma unroll
            for (int ai = 0; ai < 2; ++ai)
#pragma unroll
              for (int m = 0; m < 4; ++m)
#pragma unroll
                for (int bj = 0; bj < 2; ++bj)
#pragma unroll
                  for (int n = 0; n < 2; ++n) { const f32x4 v = acc[ai][bj][m][n];
                      uint2 o; o.x = pack2(v[0], v[1]); o.y = pack2(v[2], v[3]);
                      *(uint2*)(tl + (ai * HALF + ewr * 64 + m * 16 + efr) * 264 + bj * HALF + ewc * 32 + n * 16 + efq * 4) = o; }
            __syncthreads();
#pragma unroll 8
            for (int r = 0; r < 32; ++r) { const int row = ewave * 32 + r;
                *(uint2*)(cx.H + (size_t)(brow + row) * NH + bcol + elane * 4) = *(const uint2*)(tl + row * 264 + elane * 4); }
            __syncthreads();
            continue;
        }
        const int et = otid(); const int ewr = et >> 8, ewc = (et >> 6) & 3, efr = et & 15, efq = (et >> 4) & 3;
#pragma unroll
        for (int ai = 0; ai < 2; ++ai)
#pragma unroll
          for (int m = 0; m < 4; ++m) {
            const int row = brow + ai * HALF + ewr * 64 + m * 16 + efr;
#pragma unroll
            for (int bj = 0; bj < 2; ++bj)
#pragma unroll
              for (int n = 0; n < 2; ++n) {
                const int col = bcol + bj * HALF + ewc * 32 + n * 16 + efq * 4;
                const f32x4 v = acc[ai][bj][m][n];
                if (EPI == 0) {
                    uint2 o; o.x = pack2(v[0], v[1]); o.y = pack2(v[2], v[3]);
                    *(uint2*)(cx.H + (size_t)row * NH + col) = o;
                } else {
                    if (row < TT) {
                        const float* rs = (layer == 0) ? (row < TP ? cx.x_prompt + (size_t)row * D : cx.x_sample + (size_t)(row - TP) * D) : cx.out + (size_t)row * D;
                        const float4 xr = *(const float4*)(rs + col);
                        float4 o; o.x = ALPHA * xr.x + v[0]; o.y = ALPHA * xr.y + v[1]; o.z = ALPHA * xr.z + v[2]; o.w = ALPHA * xr.w + v[3];
                        *(float4*)(cx.out + (size_t)row * D + col) = o;
                    }
                }
            }
        }
    }
    WAIT_V(0);
    __syncthreads();
#undef SA
#undef SB
#undef STAGE
#undef LDA
#undef LDB
#undef MMA
}


DI void gemm2_sample_item(const Ctx& cx, const u16* __restrict__ Bt, const int layer, const int item, unsigned char* lds) {
    float* part = (float*)lds;
    const int tid = otid(), lane = tid & 63, wave = __builtin_amdgcn_readfirstlane(tid >> 6), fr = lane & 15, fq = lane >> 4;
    const int n0 = item * 64;
    f32x4 acc[2][4];
#pragma unroll
    for (int m = 0; m < 2; ++m)
#pragma unroll
        for (int n = 0; n < 4; ++n) acc[m][n] = (f32x4){0.f, 0.f, 0.f, 0.f};
    const u16* ap = cx.XB + (size_t)(TP + fr) * D + wave * 256 + fq * 8;
    const u16* bp = Bt + (size_t)(n0 + fr) * D + wave * 256 + fq * 8;
#pragma unroll
    for (int half = 0; half < 2; ++half) {
        bf16x8 af[2][4], bq[4][4];
#pragma unroll
        for (int ks = 0; ks < 4; ++ks) {
#pragma unroll
            for (int m = 0; m < 2; ++m) af[m][ks] = *(const bf16x8*)(ap + (size_t)m * 16 * D + (half * 4 + ks) * 32);
#pragma unroll
            for (int n = 0; n < 4; ++n) bq[n][ks] = *(const bf16x8*)(bp + (size_t)n * 16 * D + (half * 4 + ks) * 32);
        }
#pragma unroll
        for (int ks = 0; ks < 4; ++ks)
#pragma unroll
            for (int m = 0; m < 2; ++m)
#pragma unroll
                for (int n = 0; n < 4; ++n) acc[m][n] = mfma16(af[m][ks], bq[n][ks], acc[m][n]);
    }
#pragma unroll
    for (int m = 0; m < 2; ++m)
#pragma unroll
        for (int n = 0; n < 4; ++n) *(f32x4*)(part + ((wave * 8 + m * 4 + n) * 64 + lane) * 4) = acc[m][n];
    __syncthreads();
    { const int row = tid >> 4, col = (tid & 15) * 4;
      const int m = row >> 4, n = col >> 4, j = row & 3;
      float o[4];
#pragma unroll
      for (int i = 0; i < 4; ++i) { const int ln = ((row & 15) >> 2) * 16 + (col & 15) + i; float sacc = 0.f;
#pragma unroll
          for (int w = 0; w < 8; ++w) sacc += part[((w * 8 + m * 4 + n) * 64 + ln) * 4 + j];
          o[i] = sacc; }
      const float* rs = (layer == 0) ? cx.x_sample + (size_t)row * D : cx.out + (size_t)(TP + row) * D;
      const float4 xr = *(const float4*)(rs + n0 + col);
      float4 ov; ov.x = ALPHA * xr.x + o[0]; ov.y = ALPHA * xr.y + o[1]; ov.z = ALPHA * xr.z + o[2]; ov.w = ALPHA * xr.w + o[3];
      *(float4*)(cx.out + (size_t)(TP + row) * D + n0 + col) = ov; }
    { const unsigned old = arrive_counter(cx.SAMP + layer, 0u, false);
      unsigned* flag = (unsigned*)lds;
      if (threadIdx.x == 0) *flag = (old == 31u) ? 1u : 0u;
      __syncthreads();
      const bool last = (*flag != 0u);
      __syncthreads();
      if (last) sample_ln(cx, layer); }
    __syncthreads();
}

DI void transpose_item(const float* __restrict__ w, const int ldw, const int thresh, u16* __restrict__ Wt, const int item, const int ntile_n, unsigned char* lds) {
    float* tile = (float*)lds;
    const int tid = otid();
    const int kt = item / ntile_n, ntl = item % ntile_n, k0 = kt * 128, n0 = ntl * 128;
    const int ns0 = n0 + (n0 >= thresh ? 8 : 0);
    { const int n = tid & 127, kq = tid >> 7;
      float v[32];
#pragma unroll
      for (int i = 0; i < 32; ++i) v[i] = w[(size_t)(k0 + kq + 4 * i) * ldw + ns0 + n];
#pragma unroll
      for (int i = 0; i < 32; ++i) tile[(kq + 4 * i) * 129 + n] = v[i]; }
    __syncthreads();
    { const int k2 = (tid & 63) * 2, nq = tid >> 6;
#pragma unroll
      for (int i = 0; i < 16; ++i) { const int nn = nq + 8 * i;
        *(unsigned*)(Wt + (size_t)(n0 + nn) * 2048 + k0 + k2) = pack2(tile[k2 * 129 + nn], tile[(k2 + 1) * 129 + nn]); } }
    __syncthreads();
}

template <int MODE>
DI void row_phase(const Ctx& c, const int gate_layer, const int ln_layer, unsigned char* lds) {
    float* wg = (float*)lds;
    const int tid = otid(), lane = tid & 63, wave = __builtin_amdgcn_readfirstlane(tid >> 6);
    if (gate_layer >= 0) {
        const float* w = c.w_in + (size_t)gate_layer * D * DIN;
        for (int i = tid; i < 8 * 2048; i += 512) { const int k = i >> 3, j = i & 7; wg[j * 2048 + k] = w[(size_t)k * DIN + 4096 + j]; }
    }
    __syncthreads();
    const int rstep = gridDim.x * 8;
    float4 vn[8];
    { const int row = blockIdx.x * 8 + wave;
      if (row < TT) { const float* src = (MODE == 0) ? (row < TP ? c.x_prompt + (size_t)row * D : c.x_sample + (size_t)(row - TP) * D) : c.out + (size_t)row * D;
#pragma unroll
        for (int i = 0; i < 8; ++i) vn[i] = *(const float4*)(src + i * 256 + lane * 4); } }
    for (int row = blockIdx.x * 8 + wave; row < TT; row += rstep) {
        float4 v[8];
#pragma unroll
        for (int i = 0; i < 8; ++i) v[i] = vn[i];
        { const int nrow = row + rstep;
          if (nrow < TT) { const float* src = (MODE == 0) ? (nrow < TP ? c.x_prompt + (size_t)nrow * D : c.x_sample + (size_t)(nrow - TP) * D) : c.out + (size_t)nrow * D;
#pragma unroll
            for (int i = 0; i < 8; ++i) vn[i] = *(const float4*)(src + i * 256 + lane * 4); } }
        if (MODE == 1) {
            float s = 0.f;
#pragma unroll
            for (int i = 0; i < 8; ++i) s += v[i].x + v[i].y + v[i].z + v[i].w;
            const float mu = wave_sum(s) * (1.f / 2048.f);
            float q = 0.f;
#pragma unroll
            for (int i = 0; i < 8; ++i) { float a = v[i].x - mu, b = v[i].y - mu, cc = v[i].z - mu, d = v[i].w - mu; q += a * a + b * b + cc * cc + d * d; }
            const float rstd = rsqrtf(wave_sum(q) * (1.f / 2048.f) + LN_EPS);
            const float* g = c.ln_g + ln_layer * D; const float* bb = c.ln_b + ln_layer * D;
#pragma unroll
            for (int i = 0; i < 8; ++i) {
                const float4 gg = *(const float4*)(g + i * 256 + lane * 4), be = *(const float4*)(bb + i * 256 + lane * 4);
                v[i].x = (v[i].x - mu) * rstd * gg.x + be.x; v[i].y = (v[i].y - mu) * rstd * gg.y + be.y;
                v[i].z = (v[i].z - mu) * rstd * gg.z + be.z; v[i].w = (v[i].w - mu) * rstd * gg.w + be.w;
                *(float4*)(c.out + (size_t)row * D + i * 256 + lane * 4) = v[i];
            }
        }
        if (gate_layer >= 0) {
            float ga[8];
#pragma unroll
            for (int j = 0; j < 8; ++j) ga[j] = 0.f;
#pragma unroll
            for (int i = 0; i < 8; ++i) {
                uint2 o; o.x = pack2(v[i].x, v[i].y); o.y = pack2(v[i].z, v[i].w);
                *(uint2*)(c.XB + (size_t)row * D + i * 256 + lane * 4) = o;
#pragma unroll
                for (int j = 0; j < 8; ++j) { const float4 ww = *(const float4*)(wg + j * 2048 + i * 256 + lane * 4);
                    ga[j] += v[i].x * ww.x + v[i].y * ww.y + v[i].z * ww.z + v[i].w * ww.w; }
                asm volatile("" ::: "memory");
            }
#pragma unroll
            for (int j = 0; j < 8; ++j) ga[j] = wave_sum(ga[j]);
            if (lane < 4) {
                float gi = ga[0], gf = ga[4];
                if (lane == 1) { gi = ga[1]; gf = ga[5]; } else if (lane == 2) { gi = ga[2]; gf = ga[6]; } else if (lane == 3) { gi = ga[3]; gf = ga[7]; }
                c.GIG[row * 4 + lane] = gi + c.b_i[gate_layer * 4 + lane];
                const float z = gf + c.b_f[gate_layer * 4 + lane];
                c.GLF[row * 4 + lane] = fminf(z, 0.f) - __logf(1.f + __expf(-fabsf(z)));
            }
        }
    }
    __syncthreads();
}

DI void m1_item(const Ctx& c, const int unit, unsigned char* lds, const int mode = 0) {
    u16* sKt = (u16*)lds; u16* sVt = (u16*)(lds + 69632); float* fl = (float*)(lds + 139264);
    float *s_lf = fl, *s_ig = fl + 128, *s_gl = fl + 256;
    const int tid = otid(), lane = tid & 63, wave = __builtin_amdgcn_readfirstlane(tid >> 6), fr = lane & 15, fq = lane >> 4;
    const int b = unit >> 7, h = (unit >> 5) & 3, ch = unit & 31, rb = b * 4096 + ch * 128;
    if (tid < 128) { s_lf[tid] = c.GLF[(rb + tid) * 4 + h]; s_ig[tid] = c.GIG[(rb + tid) * 4 + h]; }
    bf16x8 kvr[8], vvr[8];
    { const int sl = wave * 8 + (lane & 7), dch = lane >> 3;
#pragma unroll
      for (int i = 0; i < 8; ++i) { const size_t ro = (size_t)(rb + sl + 64 * (i & 1)) * NH + h * 256 + (i >> 1) * 64 + dch * 8;
          kvr[i] = *(const bf16x8*)(c.H + ro + HK); vvr[i] = *(const bf16x8*)(c.H + ro + HV); } }
    __syncthreads();
    if (wave == 0) {
        const float x0 = s_lf[2 * lane], x1 = s_lf[2 * lane + 1]; const float loc = x0 + x1; float inc = loc;
        for (int o = 1; o < 64; o <<= 1) { const float y = __shfl_up(inc, o); if (lane >= o) inc += y; }
        const float ex = inc - loc, b0 = ex + x0, b1 = ex + loc;
        const float Btot = __int_as_float(__builtin_amdgcn_readlane(__float_as_int(inc), 63));
        const float l0 = Btot - b0 + s_ig[2 * lane], l1 = Btot - b1 + s_ig[2 * lane + 1];
        const float a = wave_max(fmaxf(l0, l1));
        s_gl[2 * lane] = __expf(l0 - a) * 0.0625f; s_gl[2 * lane + 1] = __expf(l1 - a) * 0.0625f;
        if (lane == 0) { st_wt4(c.AB + unit * 2, a); st_wt4(c.AB + unit * 2 + 1, Btot); }
    }
    __syncthreads();
    { const int sl = wave * 8 + (lane & 7), dch = lane >> 3;
#pragma unroll
      for (int i = 0; i < 8; ++i) { const int s = sl + 64 * (i & 1); const float g = s_gl[s]; const int pc = s ^ (dch << 3);
          const bf16x8 kv = kvr[i]; const bf16x8 vv = vvr[i];
#pragma unroll
        for (int e = 0; e < 8; ++e) { const int dd = (i >> 1) * 64 + dch * 8 + e; sKt[dd * 136 + pc] = f2bf(bf2f((u16)kv[e]) * g); sVt[dd * 136 + pc] = (u16)vv[e]; } } }
    __syncthreads();
    if (mode == 1) { __syncthreads(); return; }
    f32x4 acc[2][16];
#pragma unroll
    for (int m = 0; m < 2; ++m)
#pragma unroll
        for (int et = 0; et < 16; ++et) acc[m][et] = (f32x4){0.f, 0.f, 0.f, 0.f};
#pragma unroll
    for (int kk = 0; kk < 4; ++kk) {
        const int gx = (kk * 4 + fq) ^ ((fr >> 3) & 1);
        const int r0 = wave * 32 + fr, r1 = wave * 32 + 16 + fr;
        const bf16x8 a0 = *(const bf16x8*)&sKt[r0 * 136 + (((kk * 4 + fq) ^ ((r0 >> 3) & 7)) << 3)];
        const bf16x8 a1 = *(const bf16x8*)&sKt[r1 * 136 + (((kk * 4 + fq) ^ ((r1 >> 3) & 7)) << 3)];
        (void)gx;
#pragma unroll
        for (int eg = 0; eg < 16; eg += 8) { bf16x8 bv[8];
#pragma unroll
            for (int k = 0; k < 8; ++k) { const int re = (eg + k) * 16 + fr; bv[k] = *(const bf16x8*)&sVt[re * 136 + (((kk * 4 + fq) ^ ((re >> 3) & 7)) << 3)]; }
            PIN8(bv);
#pragma unroll
            for (int k = 0; k < 8; ++k) { acc[0][eg + k] = mfma16(a0, bv[k], acc[0][eg + k]); acc[1][eg + k] = mfma16(a1, bv[k], acc[1][eg + k]); } }
    }
    if (mode == 2) { float sink_ = 0.f;
#pragma unroll
        for (int m = 0; m < 2; ++m)
#pragma unroll
            for (int et = 0; et < 16; ++et) sink_ += acc[m][et][0] + acc[m][et][1] + acc[m][et][2] + acc[m][et][3];
        if (sink_ == 1.2345e-30f) c.AB[600] = sink_;
        __syncthreads(); return; }
    if (tid < 256) { float sdn = 0.f;
#pragma unroll
        for (int i = 0; i < 16; ++i) { const bf16x8 v = *(const bf16x8*)&sKt[tid * 136 + i * 8];
#pragma unroll
            for (int e = 0; e < 8; ++e) sdn += bf2f((u16)v[e]); }
        st_wt4(c.DN + unit * 256 + tid, sdn); }
    __syncthreads();
    u16* tileC = (u16*)lds;
#pragma unroll
    for (int m = 0; m < 2; ++m)
#pragma unroll
        for (int et = 0; et < 16; ++et) { const int e = et * 16 + fr, d0 = wave * 32 + m * 16 + fq * 4; const f32x4 v = acc[m][et];
            uint2 o; o.x = pack2(v[0], v[1]); o.y = pack2(v[2], v[3]); *(uint2*)(tileC + e * 264 + d0) = o; }
    __syncthreads();
    { u16* cs = c.CS + (size_t)unit * 65536;
#pragma unroll 8
      for (int r = 0; r < 32; ++r) { const int e = wave * 32 + r; st_wt8(cs + e * 256 + lane * 4, *(const uint2*)(tileC + e * 264 + lane * 4)); } }
    __syncthreads();
}

DI void scan_item(const Ctx& c, const int l, const int item, unsigned char* lds) {
    float* sa = (float*)lds; float* tileT = (float*)(lds + 1024);
    const int tid = otid(), bh = item >> 5, part = item & 31;
    if (tid < 32) { sa[tid] = ld_wt4(c.AB + (bh * 32 + tid) * 2); sa[32 + tid] = ld_wt4(c.AB + (bh * 32 + tid) * 2 + 1); }
    __syncthreads();
    if (tid == 0) { float m = 0.f;
        for (int ch = 0; ch < 32; ++ch) { const float a = sa[ch], B = sa[32 + ch]; const float me = fmaxf(B + m, a);
            sa[64 + ch] = __expf(B + m - me); sa[96 + ch] = __expf(a - me); sa[128 + ch] = m; m = me; }
        sa[160] = m; }
    __syncthreads();
    if (part == 0 && tid < 32) st_wt4(c.M0 + bh * 32 + tid, sa[128 + tid]);
    const u16* p = c.CS + (size_t)bh * 32 * 65536 + (size_t)part * 2048 + tid * 4;
    u16* p2 = c.CS2 + (size_t)bh * 32 * 65536 + (size_t)part * 2048 + tid * 4;
    float c0 = 0.f, c1 = 0.f, c2 = 0.f, c3 = 0.f;
    asm volatile("" : "+v"(c0), "+v"(c1), "+v"(c2), "+v"(c3));
    for (int cg8 = 0; cg8 < 32; cg8 += 8) {
        uint2 raw[8];
#pragma unroll
        for (int k = 0; k < 8; ++k) raw[k] = ld_wt8(p + (size_t)(cg8 + k) * 65536);
#pragma unroll
        for (int k = 0; k < 8; ++k) { const int ch = cg8 + k;
            uint2 o; o.x = pack2(c0, c1); o.y = pack2(c2, c3);
            st_wt8(p2 + (size_t)ch * 65536, o);
            const float g0 = sa[64 + ch], gs = sa[96 + ch];
            c0 = g0 * c0 + gs * bf2f((u16)(raw[k].x & 0xffff)); c1 = g0 * c1 + gs * bf2f((u16)(raw[k].x >> 16));
            c2 = g0 * c2 + gs * bf2f((u16)(raw[k].y & 0xffff)); c3 = g0 * c3 + gs * bf2f((u16)(raw[k].y >> 16)); }
    }
    { const int e_loc = tid >> 6, d = (tid & 63) * 4;
      tileT[(d + 0) * 8 + e_loc] = c0; tileT[(d + 1) * 8 + e_loc] = c1; tileT[(d + 2) * 8 + e_loc] = c2; tileT[(d + 3) * 8 + e_loc] = c3; }
    __syncthreads();
    { const int d = tid >> 1, e4 = (tid & 1) * 4;
      *(float4*)(c.out + O_CP + (size_t)(l * 8 + bh) * 65536 + d * 256 + part * 8 + e4) = *(const float4*)(tileT + d * 8 + e4); }
    if (part == 0 && tid < 256) {
        float nn = 0.f;
        float dnr[32];
#pragma unroll
        for (int ch = 0; ch < 32; ++ch) dnr[ch] = ld_wt4(c.DN + (bh * 32 + ch) * 256 + tid);
#pragma unroll
        for (int ch = 0; ch < 32; ++ch) { st_wt4(c.N0 + (bh * 32 + ch) * 256 + tid, nn); nn = sa[64 + ch] * nn + sa[96 + ch] * dnr[ch]; }
        c.out[O_NP + (l * 8 + bh) * 256 + tid] = nn;
        if (tid == 0) c.out[O_MP + l * 8 + bh] = sa[160];
    }
    __syncthreads();
}

DI void m3_item(const Ctx& c, const int l, const int unit, unsigned char* lds) {
    u16* sVt = (u16*)lds; u16* sP = (u16*)(lds + 69632); float* fl = (float*)(lds + 104448);
    float *s_lf = fl, *s_ig = fl + 128, *s_u = fl + 256, *s_M = fl + 384, *s_w0 = fl + 512, *s_emm = fl + 640, *s_qn = fl + 768, *s_rinv = fl + 896, *s_n0 = fl + 1024;
    const int tid = otid(), lane = tid & 63, wave = __builtin_amdgcn_readfirstlane(tid >> 6), fr = lane & 15, fq = lane >> 4;
    const int b = unit >> 7, h = (unit >> 5) & 3, ch = unit & 31, rb = b * 4096 + ch * 128;
    if (tid < 128) { s_lf[tid] = c.GLF[(rb + tid) * 4 + h]; s_ig[tid] = c.GIG[(rb + tid) * 4 + h]; }
    if (tid >= 256) s_n0[tid - 256] = ld_wt4(c.N0 + unit * 256 + tid - 256);
    const float m0 = ld_wt4(c.M0 + unit);
    __syncthreads();
    if (wave == 0) {
        const float x0 = s_lf[2 * lane], x1 = s_lf[2 * lane + 1]; const float loc = x0 + x1; float inc = loc;
        for (int o = 1; o < 64; o <<= 1) { const float y = __shfl_up(inc, o); if (lane >= o) inc += y; }
        const float ex = inc - loc, b0 = ex + x0, b1 = ex + loc;
        const float u0 = s_ig[2 * lane] - b0, u1 = s_ig[2 * lane + 1] - b1;
        float mx = fmaxf(u0, u1);
        for (int o = 1; o < 64; o <<= 1) { const float y = __shfl_up(mx, o); if (lane >= o) mx = fmaxf(mx, y); }
        float mprev = __shfl_up(mx, 1); if (lane == 0) mprev = -3.0e38f;
        const float M0v = fmaxf(m0, fmaxf(mprev, u0)), M1v = fmaxf(m0, mx);
        s_u[2 * lane] = u0; s_u[2 * lane + 1] = u1; s_M[2 * lane] = M0v; s_M[2 * lane + 1] = M1v;
        s_w0[2 * lane] = __expf(m0 - M0v); s_w0[2 * lane + 1] = __expf(m0 - M1v);
        s_emm[2 * lane] = __expf(-(b0 + M0v)); s_emm[2 * lane + 1] = __expf(-(b1 + M1v));
    }
    u16* sK = (u16*)lds;
    bf16x8 vvr[8];
    { const int krow = tid >> 5, kcol = (tid & 31) * 8;
      bf16x8 kk[8];
#pragma unroll
      for (int p = 0; p < 8; ++p) kk[p] = *(const bf16x8*)(c.H + (size_t)(rb + p * 16 + krow) * NH + HK + h * 256 + kcol);
      const u16* vp = c.H + (size_t)(rb + (tid & 127)) * NH + HV + h * 256 + (tid >> 7) * 64;
#pragma unroll
      for (int i = 0; i < 8; ++i) vvr[i] = *(const bf16x8*)(vp + i * 8);
#pragma unroll
      for (int p = 0; p < 8; ++p) *(bf16x8*)(sK + (p * 16 + krow) * 264 + kcol) = kk[p]; }
    { const int t = tid >> 2, qt = tid & 3; const u16* qp = c.H + (size_t)(rb + t) * NH + HQ + h * 256 + qt * 64; float s = 0.f;
#pragma unroll
      for (int i = 0; i < 8; ++i) { const bf16x8 qv = *(const bf16x8*)(qp + i * 8);
#pragma unroll
        for (int e = 0; e < 8; ++e) s += bf2f((u16)qv[e]) * s_n0[qt * 64 + i * 8 + e]; }
      s += __shfl_xor(s, 1); s += __shfl_xor(s, 2);
      if (qt == 0) s_qn[t] = s; }
    __syncthreads();
    bf16x8 qf[8];
    { const u16* qp = c.H + (size_t)(rb + wave * 16 + fr) * NH + HQ + h * 256 + fq * 8;
#pragma unroll
      for (int ks = 0; ks < 8; ++ks) qf[ks] = *(const bf16x8*)(qp + ks * 32); }
    const int nks = (wave >> 1) + 1;
    for (int js = 0; js < 2 * nks; ++js) {
        f32x4 a = (f32x4){0.f, 0.f, 0.f, 0.f};
        if (js <= wave) { bf16x8 kf[8];
#pragma unroll
            for (int ks = 0; ks < 8; ++ks) kf[ks] = *(const bf16x8*)(sK + (js * 16 + fr) * 264 + ks * 32 + fq * 8);
            PIN8(kf);
#pragma unroll
            for (int ks = 0; ks < 8; ++ks) a = mfma16(qf[ks], kf[ks], a); }
        const int si = js * 16 + fr; const float us = s_u[si];
#pragma unroll
        for (int j = 0; j < 4; ++j) { const int ti = wave * 16 + fq * 4 + j;
            const float val = (si <= ti) ? a[j] * 0.0625f * __expf(us - s_M[ti]) : 0.f;
            sP[ti * 136 + si] = f2bf(val); }
    }
    __syncthreads();
    { const int s2 = tid & 127, grp = tid >> 7;
#pragma unroll
      for (int i = 0; i < 8; ++i) { const bf16x8 vv = vvr[i];
#pragma unroll
        for (int e = 0; e < 8; ++e) sVt[(grp * 64 + i * 8 + e) * 136 + s2] = (u16)vv[e]; } }
    { const int tl = lane & 15, part = lane >> 4; float s = 0.f;
      if (part < nks) { const u16* pp = sP + (wave * 16 + tl) * 136 + part * 32;
#pragma unroll
        for (int i = 0; i < 4; ++i) { const bf16x8 v = *(const bf16x8*)(pp + i * 8);
#pragma unroll
          for (int e = 0; e < 8; ++e) s += bf2f((u16)v[e]); } }
      s += __shfl_xor(s, 16); s += __shfl_xor(s, 32);
      const int t = wave * 16 + tl;
      if (part == 0) { const float den = s + s_w0[t] * s_qn[t]; s_rinv[t] = 1.f / fmaxf(fabsf(den), s_emm[t]); } }
    __syncthreads();
    f32x4 acc[16];
#pragma unroll
    for (int et = 0; et < 16; ++et) acc[et] = (f32x4){0.f, 0.f, 0.f, 0.f};
    {
      u16* cq = (u16*)(lds + 109568);
      const u16* cs = c.CS2 + (size_t)unit * 65536;
      const int crow = tid >> 5, ccol = (tid & 31) * 8;
      bf16x8 pre[4];
#pragma unroll
      for (int p = 0; p < 4; ++p) { const u16* gp = cs + (size_t)(p * 16 + crow) * 256 + ccol; const uint2 lo = ld_wt8(gp), hi = ld_wt8(gp + 4); uint4 q4 = make_uint4(lo.x, lo.y, hi.x, hi.y); pre[p] = __builtin_bit_cast(bf16x8, q4); }
#pragma unroll
      for (int q = 0; q < 4; ++q) {
#pragma unroll
          for (int p = 0; p < 4; ++p) *(bf16x8*)(cq + (p * 16 + crow) * 264 + ccol) = pre[p];
          if (q < 3) {
#pragma unroll
              for (int p = 0; p < 4; ++p) { const u16* gp = cs + (size_t)((q + 1) * 64 + p * 16 + crow) * 256 + ccol; const uint2 lo = ld_wt8(gp), hi = ld_wt8(gp + 4); uint4 q4 = make_uint4(lo.x, lo.y, hi.x, hi.y); pre[p] = __builtin_bit_cast(bf16x8, q4); }
          }
          __syncthreads();
#pragma unroll
          for (int t4 = 0; t4 < 4; ++t4) { const int et = q * 4 + t4; bf16x8 cf[8];
#pragma unroll
              for (int ks = 0; ks < 8; ++ks) cf[ks] = *(const bf16x8*)(cq + (t4 * 16 + fr) * 264 + ks * 32 + fq * 8);
              PIN8(cf);
#pragma unroll
              for (int ks = 0; ks < 8; ++ks) acc[et] = mfma16(qf[ks], cf[ks], acc[et]); }
          __syncthreads();
      } }
    float w0r[4], rinv[4];
#pragma unroll
    for (int j = 0; j < 4; ++j) { w0r[j] = s_w0[wave * 16 + fq * 4 + j]; rinv[j] = s_rinv[wave * 16 + fq * 4 + j]; }
#pragma unroll
    for (int et = 0; et < 16; ++et)
#pragma unroll
        for (int j = 0; j < 4; ++j) acc[et][j] *= w0r[j];
#pragma unroll
    for (int ks = 0; ks < 4; ++ks) if (ks < nks) {
        const bf16x8 pf = *(const bf16x8*)&sP[(wave * 16 + fr) * 136 + ks * 32 + fq * 8];
#pragma unroll
        for (int eg = 0; eg < 16; eg += 8) { bf16x8 vf[8];
#pragma unroll
            for (int k = 0; k < 8; ++k) vf[k] = *(const bf16x8*)&sVt[((eg + k) * 16 + fr) * 136 + ks * 32 + fq * 8];
            PIN8(vf);
#pragma unroll
            for (int k = 0; k < 8; ++k) acc[eg + k] = mfma16(pf, vf[k], acc[eg + k]); }
    }
    uint2 og[16], zg[16];
#pragma unroll
    for (int r = 0; r < 16; ++r) { const size_t row = (size_t)(rb + wave * 16 + r);
        og[r] = *(const uint2*)(c.H + row * NH + HO + h * 256 + lane * 4); zg[r] = *(const uint2*)(c.H + row * NH + HZ + h * 256 + lane * 4); }
    __syncthreads();
    float* hb = (float*)lds;
#pragma unroll
    for (int et = 0; et < 16; ++et)
#pragma unroll
        for (int j = 0; j < 4; ++j) hb[(wave * 16 + fq * 4 + j) * 260 + et * 16 + fr] = acc[et][j] * rinv[j];
    __syncthreads();
    { const float4 g4 = *(const float4*)(c.mng + l * 1024 + h * 256 + lane * 4);
#pragma unroll
      for (int r = 0; r < 16; ++r) {
        const int t = wave * 16 + r; const size_t row = (size_t)(rb + t);
        const float4 hv = *(const float4*)(hb + t * 260 + lane * 4);
        const float mu = wave_sum(hv.x + hv.y + hv.z + hv.w) * (1.f / 256.f);
        const float d0 = hv.x - mu, d1 = hv.y - mu, d2 = hv.z - mu, d3 = hv.w - mu;
        const float rs = rsqrtf(wave_sum(d0 * d0 + d1 * d1 + d2 * d2 + d3 * d3) * (1.f / 256.f) + LN_EPS);
        const uint2 o2 = og[r], z2 = zg[r];
        const float o0 = bf2f((u16)(o2.x & 0xffff)), o1 = bf2f((u16)(o2.x >> 16)), o2f = bf2f((u16)(o2.y & 0xffff)), o3 = bf2f((u16)(o2.y >> 16));
        const float z0 = bf2f((u16)(z2.x & 0xffff)), z1 = bf2f((u16)(z2.x >> 16)), z2f = bf2f((u16)(z2.y & 0xffff)), z3 = bf2f((u16)(z2.y >> 16));
        uint2 ov;
        ov.x = pack2(d0 * rs * g4.x * sigm(o0) * silu(z0), d1 * rs * g4.y * sigm(o1) * silu(z1));
        ov.y = pack2(d2 * rs * g4.z * sigm(o2f) * silu(z2f), d3 * rs * g4.w * sigm(o3) * silu(z3));
        *(uint2*)(c.XB + row * D + h * 256 + lane * 4) = ov;
      } }
    __syncthreads();
}

DI void swa_item(const Ctx& c, const int l, const int item, unsigned char* lds) {
    u16* sVt = (u16*)lds;
    u16* sPw = (u16*)(lds + 35840);
    const int tid = otid(), lane = tid & 63, wave = __builtin_amdgcn_readfirstlane(tid >> 6), fr = lane & 15, fq = lane >> 4;
    const int b = item >> 7, n = (item >> 2) & 31, kv = (item >> 1) & 1, hp = item & 1;
    const int pbase = (n - 1) * 128;
    { const int jj = tid & 255, dg = tid >> 8; const int p = pbase + jj;
      const u16* vp = c.H + (size_t)(b * 4096 + (p < 0 ? 0 : p)) * NH + HAV + kv * 64 + dg * 32;
#pragma unroll
      for (int i = 0; i < 4; ++i) { bf16x8 vv = *(const bf16x8*)(vp + i * 8);
#pragma unroll
        for (int e = 0; e < 8; ++e) sVt[(dg * 32 + i * 8 + e) * 280 + jj] = (p < 0) ? (u16)0 : (u16)vv[e]; }
      for (int i = tid; i < 64 * 24; i += 512) sVt[(i / 24) * 280 + 256 + (i % 24)] = 0; }
    u16* sP = sPw + wave * 16 * 168;
    const int i0 = wave * 16;
    const size_t qrow = (size_t)(b * 4096 + n * 128 + i0);
    u16* sKw = (u16*)(lds + 78848);
    { const int kr = tid >> 3, kc = (tid & 7) * 8;
      bf16x8 kk[4];
#pragma unroll
      for (int p4 = 0; p4 < 4; ++p4) { const int jj = p4 * 64 + kr; const int p = pbase + jj;
          kk[p4] = *(const bf16x8*)(c.H + (size_t)(b * 4096 + (p < 0 ? 0 : p)) * NH + HAK + kv * 64 + kc); }
#pragma unroll
      for (int p4 = 0; p4 < 4; ++p4) *(bf16x8*)(sKw + (p4 * 64 + kr) * 72 + kc) = kk[p4]; }
    __syncthreads();
    bf16x8 kf0[9], kf1[9];
#pragma unroll
    for (int jt = 0; jt < 9; ++jt) {
        const u16* kp = sKw + (i0 + jt * 16 + fr) * 72 + fq * 8;
        kf0[jt] = *(const bf16x8*)kp; kf1[jt] = *(const bf16x8*)(kp + 32);
    }
    bf16x8 qfa[2][2];
#pragma unroll
    for (int hh = 0; hh < 2; ++hh) { const u16* qp = c.H + (qrow + fr) * NH + HAQ + (kv * 4 + hp * 2 + hh) * 64 + fq * 8; qfa[hh][0] = *(const bf16x8*)qp; qfa[hh][1] = *(const bf16x8*)(qp + 32); }
#pragma unroll
    for (int hh = 0; hh < 2; ++hh) {
    const int hq = kv * 4 + hp * 2 + hh;
    f32x4 sc[9];
#pragma unroll
    for (int jt = 0; jt < 9; ++jt) {
        f32x4 a = (f32x4){0.f, 0.f, 0.f, 0.f};
        a = mfma16(qfa[hh][0], kf0[jt], a); a = mfma16(qfa[hh][1], kf1[jt], a);
        sc[jt] = a;
    }
    const float sink = c.sinks[l * 8 + hq];
    float rmax[4], rsum[4];
#pragma unroll
    for (int j = 0; j < 4; ++j) rmax[j] = -3.0e38f;
#pragma unroll
    for (int jt = 0; jt < 9; ++jt) { const int p = pbase + i0 + jt * 16 + fr;
#pragma unroll
        for (int j = 0; j < 4; ++j) { const int rel = 128 + fq * 4 + j - jt * 16 - fr; const bool ok = (rel >= 0) && (rel <= 128) && (p >= 0);
            const float s = ok ? sc[jt][j] * 0.125f : -3.0e38f; sc[jt][j] = s; rmax[j] = fmaxf(rmax[j], s); } }
#pragma unroll
    for (int j = 0; j < 4; ++j) { float m = rmax[j]; m = fmaxf(m, __shfl_xor(m, 1)); m = fmaxf(m, __shfl_xor(m, 2)); m = fmaxf(m, __shfl_xor(m, 4)); m = fmaxf(m, __shfl_xor(m, 8));
        rmax[j] = fmaxf(m, sink); rsum[j] = 0.f; }
#pragma unroll
    for (int jt = 0; jt < 9; ++jt)
#pragma unroll
        for (int j = 0; j < 4; ++j) { const float e = (sc[jt][j] > -1.0e38f) ? __expf(sc[jt][j] - rmax[j]) : 0.f; sc[jt][j] = e; rsum[j] += e; }
#pragma unroll
    for (int j = 0; j < 4; ++j) { float s = rsum[j]; s += __shfl_xor(s, 1); s += __shfl_xor(s, 2); s += __shfl_xor(s, 4); s += __shfl_xor(s, 8);
        rsum[j] = 1.f / (s + __expf(sink - rmax[j])); }
#pragma unroll
    for (int jt = 0; jt < 9; ++jt)
#pragma unroll
        for (int j = 0; j < 4; ++j) sP[(fq * 4 + j) * 168 + jt * 16 + fr] = f2bf(sc[jt][j] * rsum[j]);
#pragma unroll
    for (int j = 0; j < 4; ++j) sP[(fq * 4 + j) * 168 + 144 + fr] = 0;
    __syncthreads();
    f32x4 oacc[4];
#pragma unroll
    for (int dt = 0; dt < 4; ++dt) oacc[dt] = (f32x4){0.f, 0.f, 0.f, 0.f};
#pragma unroll
    for (int ks = 0; ks < 5; ++ks) { const bf16x8 pf = *(const bf16x8*)&sP[fr * 168 + ks * 32 + fq * 8];
#pragma unroll
        for (int dt = 0; dt < 4; ++dt) { const bf16x8 vf = *(const bf16x8*)&sVt[(dt * 16 + fr) * 280 + i0 + ks * 32 + fq * 8]; oacc[dt] = mfma16(pf, vf, oacc[dt]); } }
#pragma unroll
    for (int dt = 0; dt < 4; ++dt)
#pragma unroll
        for (int j = 0; j < 4; ++j) { const size_t row = qrow + fq * 4 + j; const int d = dt * 16 + fr;
            const float az = bf2f(c.H[row * NH + HAZ + hq * 64 + d]);
            c.XB[row * D + 1536 + hq * 64 + d] = f2bf(oacc[dt][j] * silu(az)); }
    __syncthreads();
    }
}

DI void conv_item(const Ctx& c, const int l, const int item, unsigned char* lds) {
    float* pst = (float*)lds;
    float* st = pst + 512;
    const int tid = otid(), lane = tid & 63, wave = __builtin_amdgcn_readfirstlane(tid >> 6);
    const int b = item >> 7, tl = item & 127, t0 = tl * 32;
    float a[62];
    { const u16* hu = c.H + (size_t)(b * 4096) * NH + HCU + tid; const u16* hg = c.H + (size_t)(b * 4096) * NH + HCG + tid;
#pragma unroll
      for (int r0 = 0; r0 < 62; r0 += 31) {
          u16 uu[31], gg[31];
#pragma unroll
          for (int k = 0; k < 31; ++k) { const int tt = t0 - 30 + r0 + k; const size_t ro = (size_t)(tt < 0 ? 0 : tt) * NH; uu[k] = hu[ro]; gg[k] = hg[ro]; }
#pragma unroll
          for (int k = 0; k < 31; ++k) { const int tt = t0 - 30 + r0 + k; a[r0 + k] = (tt >= 0) ? bf2f(uu[k]) * sigm(bf2f(gg[k])) : 0.f; }
      } }
    if (tl == 127) {
#pragma unroll
        for (int r = 32; r < 62; ++r) c.out[O_CONVP + (size_t)((l * 2 + b) * 30 + (r - 32)) * 512 + tid] = a[r];
    }
    float y[32];
    { float w[31];
#pragma unroll
      for (int j = 0; j < 31; ++j) w[j] = c.conv_w[(l * 31 + j) * 512 + tid];
      const float cb = c.conv_b[l * 512 + tid];
#pragma unroll
      for (int t = 0; t < 32; ++t) { float acc = cb;
#pragma unroll
          for (int j = 0; j < 31; ++j) acc += w[j] * a[t + j];
          y[t] = acc; } }
    u16 czr[32];
#pragma unroll
    for (int t = 0; t < 32; ++t) czr[t] = c.H[(size_t)(b * 4096 + t0 + t) * NH + HCZ + tid];
    float* sy = (float*)(lds + 4096);
#pragma unroll
    for (int t = 0; t < 32; ++t) sy[t * 512 + tid] = y[t];
    __syncthreads();
#pragma unroll
    for (int k = 0; k < 4; ++k) { const int t = wave * 4 + k; float s = 0.f, q = 0.f;
#pragma unroll
        for (int i = 0; i < 8; ++i) { const float v = sy[t * 512 + lane + 64 * i]; s += v; q += v * v; }
        s = wave_sum(s); q = wave_sum(q);
        if (lane == 0) { const float mu = s * (1.f / 512.f); st[t * 2] = mu; st[t * 2 + 1] = rsqrtf(fmaxf(q * (1.f / 512.f) - mu * mu, 0.f) + LN_EPS); } }
    __syncthreads();
    const float lg = c.cln_g[l * 512 + tid], lb = c.cln_b[l * 512 + tid];
#pragma unroll
    for (int t = 0; t < 32; ++t) { const size_t row = (size_t)(b * 4096 + t0 + t);
        const float yn = (y[t] - st[t * 2]) * st[t * 2 + 1] * lg + lb;
        c.XB[row * D + 1024 + tid] = f2bf(silu(yn) * silu(bf2f(czr[t]))); }
    __syncthreads();
}

DI float block_sum512(float v, float* red) {
    v = wave_sum(v);
    __syncthreads();
    if ((threadIdx.x & 63) == 0) red[threadIdx.x >> 6] = v;
    __syncthreads();
    float s = 0.f;
#pragma unroll
    for (int i = 0; i < 8; ++i) s += red[i];
    return s;
}

DI void smlstm_item(const Ctx& c, const int l, const int item, unsigned char* lds) {
    float* sq = (float*)lds; float* sk = sq + 256; float* sv = sq + 512; float* sn = sq + 768; float* red = sq + 1024; float* part = sq + 1040;
    const int tid = otid(), b = item >> 2, h = item & 3;
    const size_t row = (size_t)(TP + b);
    const size_t sidx = (size_t)((l * 32 + b) * 4 + h);
    if (tid < 256) { sq[tid] = bf2f(c.H[row * NH + HQ + h * 256 + tid]); sk[tid] = bf2f(c.H[row * NH + HK + h * 256 + tid]) * 0.0625f;
        sv[tid] = bf2f(c.H[row * NH + HV + h * 256 + tid]); sn[tid] = c.state_n[sidx * 256 + tid]; }
    __syncthreads();
    const float qk = block_sum512(tid < 256 ? sq[tid] * sk[tid] : 0.f, red);
    const float qn = block_sum512(tid < 256 ? sq[tid] * sn[tid] : 0.f, red);
    const float m0 = c.state_m[sidx], ig = c.GIG[row * 4 + h], lf = c.GLF[row * 4 + h];
    const float m = fmaxf(lf + m0, ig);
    const float wg = __expf(ig - m), w0 = __expf(lf + m0 - m);
    const float s = qk * wg;
    const float den = s + w0 * qn;
    const float rinv = 1.f / fmaxf(fabsf(den), __expf(-m));
    if (tid == 0) c.out[O_MS + sidx] = m;
    if (tid < 256) c.out[O_NS + sidx * 256 + tid] = w0 * sn[tid] + wg * sk[tid];
    { const int e4 = (tid & 63) * 4, dg = tid >> 6;
      const float* C0 = c.state_C + sidx * 65536; float* Cn = c.out + O_CS + sidx * 65536;
      const float4 v4 = *(const float4*)(sv + e4);
      float4 acc = make_float4(0.f, 0.f, 0.f, 0.f);
      for (int d0 = 0; d0 < 32; d0 += 16) {
          float4 cc8[16];
#pragma unroll
          for (int k = 0; k < 16; ++k) cc8[k] = *(const float4*)(C0 + (dg * 32 + d0 + k) * 256 + e4);
#pragma unroll
          for (int k = 0; k < 16; ++k) { const int d = dg * 32 + d0 + k; const float4 cc = cc8[k];
              const float qd = sq[d], gk = wg * sk[d];
              acc.x += qd * cc.x; acc.y += qd * cc.y; acc.z += qd * cc.z; acc.w += qd * cc.w;
              float4 o; o.x = w0 * cc.x + gk * v4.x; o.y = w0 * cc.y + gk * v4.y; o.z = w0 * cc.z + gk * v4.z; o.w = w0 * cc.w + gk * v4.w;
              *(float4*)(Cn + d * 256 + e4) = o; }
      }
      *(float4*)(part + dg * 256 + e4) = acc; }
    __syncthreads();
    float hv = 0.f;
    if (tid < 256) { float qc = 0.f;
#pragma unroll
        for (int g = 0; g < 8; ++g) qc += part[g * 256 + tid];
        hv = (s * sv[tid] + w0 * qc) * rinv; }
    const float mu = block_sum512(tid < 256 ? hv : 0.f, red) * (1.f / 256.f);
    const float dl = (tid < 256) ? hv - mu : 0.f;
    const float var = block_sum512(dl * dl, red) * (1.f / 256.f);
    if (tid < 256) { const float hn = dl * rsqrtf(var + LN_EPS) * c.mng[l * 1024 + h * 256 + tid];
        const float o = bf2f(c.H[row * NH + HO + h * 256 + tid]), z = bf2f(c.H[row * NH + HZ + h * 256 + tid]);
        c.XB[row * D + h * 256 + tid] = f2bf(hn * sigm(o) * silu(z)); }
    __syncthreads();
}

DI void sconv_item(const Ctx& c, const int l, const int b, unsigned char* lds) {
    float* red = (float*)lds;
    const int tid = otid(); const size_t row = (size_t)(TP + b);
    const float u = bf2f(c.H[row * NH + HCU + tid]), g = bf2f(c.H[row * NH + HCG + tid]);
    const float a = u * sigm(g);
    const float* buf = c.state_conv + (size_t)(l * 32 + b) * 30 * 512; float* nb = c.out + O_CONVS + (size_t)(l * 32 + b) * 30 * 512;
    float y = c.conv_b[l * 512 + tid] + c.conv_w[(l * 31 + 30) * 512 + tid] * a;
    { float bv[30], wv[30];
#pragma unroll
      for (int j = 0; j < 30; ++j) { bv[j] = buf[j * 512 + tid]; wv[j] = c.conv_w[(l * 31 + j) * 512 + tid]; }
#pragma unroll
      for (int j = 0; j < 30; ++j) { y += wv[j] * bv[j]; if (j > 0) nb[(j - 1) * 512 + tid] = bv[j]; } }
    nb[29 * 512 + tid] = a;
    const float mu = block_sum512(y, red) * (1.f / 512.f);
    const float dl = y - mu;
    const float var = block_sum512(dl * dl, red) * (1.f / 512.f);
    const float yn = dl * rsqrtf(var + LN_EPS) * c.cln_g[l * 512 + tid] + c.cln_b[l * 512 + tid];
    const float cz = bf2f(c.H[row * NH + HCZ + tid]);
    c.XB[row * D + 1024 + tid] = f2bf(silu(yn) * silu(cz));
    __syncthreads();
}

DI void sattn_item(const Ctx& c, const int l, const int b, unsigned char* lds) {
    float* sq = (float*)lds;
    float* sp = sq + 512;
    const int tid = otid(), lane = tid & 63, w = tid >> 6, kv = w >> 2; const size_t row = (size_t)(TP + b);
    const float* ck = c.cache_k + (size_t)(l * 32 + b) * 128 * 128; const float* cv = c.cache_v + (size_t)(l * 32 + b) * 128 * 128;
    const float qd = bf2f(c.H[row * NH + HAQ + w * 64 + lane]);
    const float kn = bf2f(c.H[row * NH + HAK + kv * 64 + lane]), vn = bf2f(c.H[row * NH + HAV + kv * 64 + lane]);
    sq[w * 64 + lane] = qd;
    __syncthreads();
    float s0 = 0.f, s1 = 0.f;
    { const float* k0 = ck + (size_t)lane * 128 + kv * 64; const float* k1 = ck + (size_t)(lane + 64) * 128 + kv * 64;
#pragma unroll
      for (int i = 0; i < 16; ++i) { const float4 a = *(const float4*)(k0 + i * 4), bb = *(const float4*)(k1 + i * 4); const float4 q4 = *(const float4*)(sq + w * 64 + i * 4);
          s0 += a.x * q4.x + a.y * q4.y + a.z * q4.z + a.w * q4.w; s1 += bb.x * q4.x + bb.y * q4.y + bb.z * q4.z + bb.w * q4.w; } }
    const float s2 = wave_sum(qd * kn) * 0.125f;
    s0 *= 0.125f; s1 *= 0.125f;
    const float sink = c.sinks[l * 8 + w];
    const float m = fmaxf(fmaxf(wave_max(fmaxf(s0, s1)), s2), sink);
    const float e0 = __expf(s0 - m), e1 = __expf(s1 - m), e2 = __expf(s2 - m);
    const float inv = 1.f / (wave_sum(e0 + e1) + e2 + __expf(sink - m));
    sp[w * 132 + lane] = e0 * inv; sp[w * 132 + 64 + lane] = e1 * inv;
    __syncthreads();
    float o = e2 * inv * vn;
    for (int j0 = 0; j0 < 128; j0 += 16) { float vv[16];
#pragma unroll
        for (int k = 0; k < 16; ++k) vv[k] = cv[(size_t)(j0 + k) * 128 + kv * 64 + lane];
#pragma unroll
        for (int k = 0; k < 16; ++k) o += sp[w * 132 + j0 + k] * vv[k]; }
    const float az = bf2f(c.H[row * NH + HAZ + w * 64 + lane]);
    c.XB[row * D + 1536 + w * 64 + lane] = f2bf(o * silu(az));
    float* nk = c.out + O_KS + (size_t)(l * 32 + b) * 16384; float* nv = c.out + O_VS + (size_t)(l * 32 + b) * 16384;
    for (int i0 = tid; i0 < 127 * 128; i0 += 512 * 8) { float kk[8], vv[8];
#pragma unroll
        for (int k = 0; k < 8; ++k) { const int i = i0 + k * 512; const int ii = i < 127 * 128 ? i : 0; kk[k] = ck[ii + 128]; vv[k] = cv[ii + 128]; }
#pragma unroll
        for (int k = 0; k < 8; ++k) { const int i = i0 + k * 512; if (i < 127 * 128) { nk[i] = kk[k]; nv[i] = vv[k]; } } }
    if (tid < 128) { nk[127 * 128 + tid] = bf2f(c.H[row * NH + HAK + tid]); nv[127 * 128 + tid] = bf2f(c.H[row * NH + HAV + tid]); }
    __syncthreads();
}

DI void pkv_item(const Ctx& c, const int l, const int b) {
    float* nk = c.out + O_KP + (size_t)(l * 2 + b) * 16384; float* nv = c.out + O_VP + (size_t)(l * 2 + b) * 16384;
    const int t0 = otid();
    for (int i0 = t0; i0 < 16384; i0 += 512 * 8) { u16 kk[8], vv[8];
#pragma unroll
        for (int k = 0; k < 8; ++k) { const int i = i0 + k * 512; const size_t row = (size_t)(b * 4096 + 3968 + (i >> 7)); const int cc = i & 127; kk[k] = c.H[row * NH + HAK + cc]; vv[k] = c.H[row * NH + HAV + cc]; }
#pragma unroll
        for (int k = 0; k < 8; ++k) { const int i = i0 + k * 512; nk[i] = bf2f(kk[k]); nv[i] = bf2f(vv[k]); } }
}

typedef const __attribute__((address_space(4))) Args* KArgs;
DI void make_ctx(Ctx& c) {
#if defined(__HIP_DEVICE_COMPILE__)
    KArgs p = (KArgs)__builtin_amdgcn_kernarg_segment_ptr();
    asm volatile("" : "+s"(p));
    const Args a = *p;
    c.x_prompt = a.in[0]; c.x_sample = a.in[1]; c.state_C = a.in[2]; c.state_n = a.in[3]; c.state_m = a.in[4]; c.state_conv = a.in[5];
    c.cache_k = a.in[6]; c.cache_v = a.in[7]; c.w_in = a.in[8]; c.w_out = a.in[9]; c.b_i = a.in[10]; c.b_f = a.in[11]; c.mng = a.in[12];
    c.conv_w = a.in[13]; c.conv_b = a.in[14]; c.cln_g = a.in[15]; c.cln_b = a.in[16]; c.sinks = a.in[17]; c.ln_g = a.in[18]; c.ln_b = a.in[19];
    c.out = a.out;
    c.XB = (u16*)(a.ws + WS_XB); c.WTI = (u16*)(a.ws + WS_WTI); c.WTO = (u16*)(a.ws + WS_WTO); c.H = (u16*)(a.ws + WS_H); c.CS = (u16*)(a.ws + WS_CSB);
    c.DN = (float*)(a.ws + WS_DN); c.AB = (float*)(a.ws + WS_AB); c.M0 = (float*)(a.ws + WS_M0); c.GIG = (float*)(a.ws + WS_GIG); c.GLF = (float*)(a.ws + WS_GLF);
    c.CS2 = (u16*)(a.ws + WS_CS2); c.N0 = (float*)(a.ws + WS_N0);
    c.STATP = (float*)(a.ws + WS_STATP); c.GPART = (float*)(a.ws + WS_GPART); c.GW = (float*)(a.ws + WS_GW);
    c.PANEL = (unsigned*)(a.ws + WS_BAR + 64); c.SAMP = (unsigned*)(a.ws + WS_BAR + 320);
    c.MCNT = (unsigned*)(a.ws + WS_BAR + 336); c.SCNT = (unsigned*)(a.ws + WS_BAR + 400); c.QCNT = (unsigned*)(a.ws + WS_BAR + 472);
#endif
}

DI void grid_barrier(unsigned* bar, const unsigned target) {
    asm volatile("s_waitcnt vmcnt(0)" ::: "memory");
    __syncthreads();
    if (threadIdx.x == 0) {
        __builtin_amdgcn_fence(__ATOMIC_RELEASE, "agent");
        asm volatile("s_waitcnt vmcnt(0)" ::: "memory");
        (void)__hip_atomic_fetch_add(bar, 1u, __ATOMIC_RELAXED, __HIP_MEMORY_SCOPE_AGENT);
        unsigned sp = 0;
        while (__hip_atomic_load(bar, __ATOMIC_RELAXED, __HIP_MEMORY_SCOPE_AGENT) < target) { __builtin_amdgcn_s_sleep(1); if (++sp > (1u << 24)) break; }
        __builtin_amdgcn_fence(__ATOMIC_ACQUIRE, "agent");
        asm volatile("s_waitcnt vmcnt(0)" ::: "memory");
    }
    __syncthreads();
}
#define GSYNC1() do { ++nsync; grid_barrier((unsigned*)(((KArgs)__builtin_amdgcn_kernarg_segment_ptr())->ws + WS_BAR), nsync * (unsigned)gridDim.x); } while (0)
#define GSYNC() do { GSYNC1(); if (GS2) GSYNC1(); } while (0)


#define PROBE_DUMP(stage, SRC16, NSRC) if (PROBE_STAGE == (stage)) { GSYNC(); Ctx c; make_ctx(c); const int tid = otid(); \
      for (size_t i = (size_t)bid * 512 + tid; i < 38011152; i += (size_t)G * 512) { float v = 0.0f; \
          if (i < O_YS) { const size_t j = i * 4; if (j < (size_t)(NSRC)) v = bf2f((SRC16)[j]); } \
          else if (PROBE_AUX && i < O_CP) { const size_t j = i - O_YS; v = (PROBE_STAGE == 3) ? c.N0[j] : ((j < 32896) ? c.GIG[j] : c.GLF[j - 32896 < 32896 ? j - 32896 : 0]); } \
          else if (PROBE_AUX && i < O_CP + 256) { v = c.M0[i - O_CP]; } else if (PROBE_AUX && i < O_CP + 768) { v = c.AB[i - O_CP - 256]; } \
          c.out[i] = v; } \
      return; }

__global__ void __launch_bounds__(512, 2) mk_fwd(Args a_unused) {
    extern __shared__ __attribute__((aligned(16))) unsigned char lds[];
    const int G = gridDim.x, bid = blockIdx.x;
    unsigned nsync = 0;
#if PROBE_POISON
    { Ctx c; make_ctx(c); const int tid = otid();
      for (int i = tid; i < LDS_BYTES / 16; i += 512) ((uint4*)lds)[i] = make_uint4(~0u, ~0u, ~0u, ~0u);
      uint4* w4 = (uint4*)c.XB;
      for (size_t i = (size_t)bid * 512 + tid; i < (size_t)285872640 / 16; i += (size_t)G * 512) if (i < WS_BAR / 16 || i >= WS_CS2 / 16) w4[i] = make_uint4(~0u, ~0u, ~0u, ~0u);
      uint4* o4 = (uint4*)c.out;
      for (size_t i = (size_t)bid * 512 + tid; i < (size_t)38011152 / 4; i += (size_t)G * 512) o4[i] = make_uint4(~0u, ~0u, ~0u, ~0u);
      __syncthreads(); }
    GSYNC();
#endif

    for (int rep = 0; rep < 1 + (REPEAT_MASK & 1); ++rep) { Ctx c; make_ctx(c);
      row_phase<0>(c, 0, 0, lds);
      const int tid = otid();
      for (size_t i = (size_t)bid * 512 + tid; i < (size_t)(MP - TT) * D / 8; i += (size_t)G * 512) ((uint4*)(c.XB + (size_t)TT * D))[i] = make_uint4(0, 0, 0, 0);
      for (int i = bid * 512 + tid; i < 2 * 8 * 2048; i += G * 512) { const int ll = i >> 14, j = (i >> 11) & 7, k = i & 2047; c.GW[i] = c.w_in[(size_t)ll * D * DIN + (size_t)k * DIN + 4096 + j]; }
      for (int it = bid; it < 992; it += G) transpose_item(c.w_in, DIN, 4096, c.WTI, it, 62, lds);
      }
    { asm volatile("s_waitcnt vmcnt(0)" ::: "memory"); __syncthreads();
      if (threadIdx.x == 0) { __builtin_amdgcn_fence(__ATOMIC_RELEASE, "agent"); asm volatile("s_waitcnt vmcnt(0)" ::: "memory"); }
      cg::this_grid().sync();
      if (threadIdx.x == 0) { __builtin_amdgcn_fence(__ATOMIC_ACQUIRE, "agent"); asm volatile("s_waitcnt vmcnt(0)" ::: "memory"); }
      __syncthreads(); }

    for (int l = 0; l < 2; ++l) {
        if (l == 1) { Ctx c; make_ctx(c); const int tid = otid();
            for (int i = bid * 512 + tid; i < TP * 8; i += G * 512) { const int row = i >> 3, j = i & 7; float sacc = 0.f;
#pragma unroll
                for (int p = 0; p < 8; ++p) sacc += c.GPART[((size_t)row * 8 + p) * 8 + j];
                if (j < 4) c.GIG[row * 4 + j] = sacc + c.b_i[4 + j];
                else { const float z = sacc + c.b_f[4 + (j - 4)]; c.GLF[row * 4 + (j - 4)] = fminf(z, 0.f) - __logf(1.f + __expf(-fabsf(z))); } } }
        for (int rep = 0; rep < 1 + ((REPEAT_MASK >> 1) & 1); ++rep) { Ctx c; make_ctx(c); gemm_phase<0>(c.XB, c.WTI, MP / 256, NH / 256, c, l, lds); }
        GSYNC();
        PROBE_DUMP(1, c.H, (size_t)MP * NH)
        { const int n_items = 962 + (l == 0 ? 992 + 512 : 0);
          for (int it = bid; it < 256; it += G) { Ctx c; make_ctx(c); m1_item(c, it, lds); publish_counter_wt(c.MCNT + l * 8 + (it >> 5)); }
          { Ctx c; make_ctx(c);
            for (int it = bid; it < 256; it += G) { wait_counter_wt(c.MCNT + l * 8 + (it >> 5), 32u); scan_item(c, l, it, lds); publish_counter_wt(c.SCNT + l * 8 + (it >> 5)); } }
          { int it = 256 + bid;
            while (it < n_items) {
              Ctx c; make_ctx(c);
              int nxt = 0;
              if (threadIdx.x == 0) nxt = 256 + G + (int)__hip_atomic_fetch_add(c.QCNT + l, 1u, __ATOMIC_RELAXED, __HIP_MEMORY_SCOPE_AGENT);
              if (it < 512) swa_item(c, l, it - 256, lds);
              else if (it < 768) conv_item(c, l, it - 512, lds);
              else if (it < 896) smlstm_item(c, l, it - 768, lds);
              else if (it < 928) sconv_item(c, l, it - 896, lds);
              else if (it < 960) sattn_item(c, l, it - 928, lds);
              else if (it < 962) pkv_item(c, l, it - 960);
              else if (it < 962 + 992) transpose_item(c.w_in + (size_t)D * DIN, DIN, 4096, c.WTI, it - 962, 62, lds);
              else { const int j = it - (962 + 992), ll = j >> 8; transpose_item(c.w_out + (size_t)ll * D * D, D, 1 << 30, c.WTO + (size_t)ll * D * D, j & 255, 16, lds); }
              volatile int* slot = (volatile int*)(lds + LDS_BYTES - 16);
              __syncthreads();
              if (threadIdx.x == 0) *slot = nxt;
              __syncthreads();
              it = *slot;
            } }
          { Ctx c; make_ctx(c);
            for (int it = bid; it < 256; it += G) { wait_counter_wt(c.SCNT + l * 8 + (it >> 5), 32u); m3_item(c, l, it, lds); } }
        }
        GSYNC();
        { Ctx c; make_ctx(c); gemm_phase<2>(c.XB, c.WTO + (size_t)l * D * D, TP / 256, D / 256, c, l, lds);
          for (int it = bid; it < 32; it += G) gemm2_sample_item(c, c.WTO + (size_t)l * D * D, l, it, lds); }
        if (l == 0) GSYNC();
    }
#if OUT_MASK
    GSYNC();
    { Ctx c; make_ctx(c); const int tid = otid();
      const size_t lo[6] = {O_YP, O_YS, O_CP, O_CONVP, O_CS, O_CONVS}, hi[6] = {O_YS, O_CP, O_CONVP, O_CS, O_CONVS, 38011152};
#pragma unroll
      for (int g = 0; g < 6; ++g) if ((OUT_MASK >> g) & 1)
          for (size_t i = lo[g] + (size_t)bid * 512 + tid; i < hi[g]; i += (size_t)G * 512) c.out[i] = 1.0f; }
#endif
}

extern "C" void kernel_launch(void* const* d_in, const int* in_sizes, int n_in,
                              void* d_out, int out_size, void* d_ws, size_t ws_size,
                              hipStream_t stream) {
    static int grid_blocks = 0;
    if (!grid_blocks) {
        int dev = 0, cus = 0, per_cu = 0;
        (void)hipGetDevice(&dev);
        (void)hipDeviceGetAttribute(&cus, hipDeviceAttributeMultiprocessorCount, dev);
        (void)hipFuncSetAttribute((const void*)mk_fwd, hipFuncAttributeMaxDynamicSharedMemorySize, LDS_BYTES);
        (void)hipOccupancyMaxActiveBlocksPerMultiprocessor(&per_cu, (const void*)mk_fwd, 512, LDS_BYTES);
        grid_blocks = cus > 0 ? cus : 256;
        if (per_cu < 1) fprintf(stderr, "occupancy query says %d blocks/CU\n", per_cu);
    }
    (void)hipMemsetAsync((unsigned char*)d_ws + WS_BAR, 0, 512, stream);
    Args a{};
    for (int i = 0; i < 20; ++i) a.in[i] = (const float*)d_in[i];
    a.out = (float*)d_out; a.ws = (unsigned char*)d_ws;
    void* args[] = {&a};
    hipError_t e = hipLaunchCooperativeKernel((const void*)mk_fwd, dim3(grid_blocks), dim3(512), args, LDS_BYTES, stream);
    if (e != hipSuccess) fprintf(stderr, "cooperative launch failed: %s (grid %d)\n", hipGetErrorString(e), grid_blocks);
}
```

```cpp
#include <hip/hip_runtime.h>
#include <hip/hip_bf16.h>
#include <hip/hip_cooperative_groups.h>
#include <cstdio>
namespace cg = cooperative_groups;

typedef unsigned short u16;
typedef __attribute__((ext_vector_type(8))) short bf16x8;
typedef __attribute__((ext_vector_type(4))) float f32x4;
#define DI __device__ __forceinline__

#ifndef REPEAT_MASK
#define REPEAT_MASK 0
#endif
#ifndef M1_MODE
#define M1_MODE 0
#endif
#ifndef GS2
#define GS2 0
#endif
#ifndef OUT_MASK
#define OUT_MASK 0
#endif
#ifndef PROBE_STAGE
#define PROBE_STAGE 0
#endif
#ifndef PROBE_POISON
#define PROBE_POISON 0
#endif
#ifndef PROBE_AUX
#define PROBE_AUX 0
#endif
#ifndef M3_DBG
#define M3_DBG 0
#endif
#ifndef M3_PCONST
#define M3_PCONST 0
#endif
#ifndef M3_SKIP
#define M3_SKIP 0
#endif
#ifndef SAFE_GEMM
#define SAFE_GEMM 0
#endif
#ifndef STRONG_SYNC
#define STRONG_SYNC 1
#endif
constexpr int LDS_BYTES = 147456;
constexpr int D = 2048, TP = 8192, TT = 8224, MP = 8448, NH = 7936, DIN = 7944;
constexpr int HQ = 0, HK = 1024, HV = 2048, HO = 3072, HZ = 4096, HCU = 5120, HCG = 5632, HCZ = 6144, HAQ = 6656, HAK = 7168, HAV = 7296, HAZ = 7424;
constexpr float ALPHA = 1.41421356237309515f;
constexpr float LN_EPS = 1e-5f;

constexpr size_t O_YP = 0, O_YS = 16777216, O_CP = 16842752, O_NP = 17891328, O_MP = 17895424, O_CONVP = 17895440,
                 O_KP = 17956880, O_VP = 18022416, O_CS = 18087952, O_NS = 34865168, O_MS = 34930704, O_CONVS = 34930960,
                 O_KS = 35914000, O_VS = 36962576;
constexpr size_t WS_XB = 0, WS_WTI = 34603008, WS_WTO = 67108864, WS_H = 83886080, WS_CSB = 217972736, WS_DN = 251527168,
                 WS_AB = 251789312, WS_M0 = 251791360, WS_GIG = 251792384, WS_GLF = 251923968, WS_BAR = 252055552, WS_CS2 = 252056064, WS_N0 = 285610496,
                 WS_STATP = 285872640, WS_GPART = 286396928, WS_GW = 288494080;

struct Args { const float* in[20]; float* out; unsigned char* ws; };
struct Ctx {
    const float *x_prompt, *x_sample, *state_C, *state_n, *state_m, *state_conv, *cache_k, *cache_v, *w_in, *w_out, *b_i, *b_f, *mng,
        *conv_w, *conv_b, *cln_g, *cln_b, *sinks, *ln_g, *ln_b;
    float* out;
    u16 *XB, *WTI, *WTO, *H, *CS, *CS2;
    float *DN, *AB, *M0, *GIG, *GLF, *N0, *STATP, *GPART, *GW;
    unsigned *PANEL, *SAMP, *MCNT, *SCNT, *QCNT;
};

DI int otid() { int t = threadIdx.x; asm volatile("" : "+v"(t)); return t; }
DI u16 f2bf(float x) { unsigned u = __float_as_uint(x); u += 0x7fffu + ((u >> 16) & 1u); return (u16)(u >> 16); }
DI float bf2f(u16 h) { return __uint_as_float(((unsigned)h) << 16); }
DI unsigned pack2(float a, float b) { return (unsigned)f2bf(a) | ((unsigned)f2bf(b) << 16); }
DI float sigm(float x) { return 1.f / (1.f + __expf(-x)); }
DI float silu(float x) { return x / (1.f + __expf(-x)); }
DI float wave_sum(float v) { for (int o = 32; o > 0; o >>= 1) v += __shfl_xor(v, o); return v; }
DI float wave_max(float v) { for (int o = 32; o > 0; o >>= 1) v = fmaxf(v, __shfl_xor(v, o)); return v; }
#define PIN8(x) asm volatile("" : "+v"(x[0]), "+v"(x[1]), "+v"(x[2]), "+v"(x[3]), "+v"(x[4]), "+v"(x[5]), "+v"(x[6]), "+v"(x[7]))
DI f32x4 mfma16(bf16x8 a, bf16x8 b, f32x4 c) { return __builtin_amdgcn_mfma_f32_16x16x32_bf16(a, b, c, 0, 0, 0); }


constexpr int BM = 256, BK = 64, HALF = 128, NXCD = 8, WGM = 8, HT = HALF * BK, GK = 2048;
DI void publish_counter(unsigned* cnt) {
    asm volatile("s_waitcnt vmcnt(0)" ::: "memory");
    __syncthreads();
    if (threadIdx.x == 0) {
        __builtin_amdgcn_fence(__ATOMIC_RELEASE, "agent");
        asm volatile("s_waitcnt vmcnt(0)" ::: "memory");
        (void)__hip_atomic_fetch_add(cnt, 1u, __ATOMIC_RELAXED, __HIP_MEMORY_SCOPE_AGENT);
    }
}
DI void wait_counter(unsigned* cnt, const unsigned target) {
    if (threadIdx.x == 0) {
        unsigned sp = 0;
        while (__hip_atomic_load(cnt, __ATOMIC_RELAXED, __HIP_MEMORY_SCOPE_AGENT) < target) { __builtin_amdgcn_s_sleep(2); if (++sp > (1u << 24)) break; }
        __builtin_amdgcn_fence(__ATOMIC_ACQUIRE, "agent");
        asm volatile("s_waitcnt vmcnt(0)" ::: "memory");
    }
    __syncthreads();
}

DI void st_wt8(void* p, const uint2 v) { __hip_atomic_store((unsigned long long*)p, ((unsigned long long)v.y << 32) | (unsigned long long)v.x, __ATOMIC_RELAXED, __HIP_MEMORY_SCOPE_AGENT); }
DI void st_wt4(float* p, const float v) { __hip_atomic_store(p, v, __ATOMIC_RELAXED, __HIP_MEMORY_SCOPE_AGENT); }
DI uint2 ld_wt8(const void* p) { const unsigned long long v = __hip_atomic_load((const unsigned long long*)p, __ATOMIC_RELAXED, __HIP_MEMORY_SCOPE_AGENT); uint2 r; r.x = (unsigned)v; r.y = (unsigned)(v >> 32); return r; }
DI float ld_wt4(const float* p) { return __hip_atomic_load(p, __ATOMIC_RELAXED, __HIP_MEMORY_SCOPE_AGENT); }
DI void wait_counter_wt(unsigned* cnt, const unsigned target) {
    if (threadIdx.x == 0) { unsigned sp = 0;
        while (__hip_atomic_load(cnt, __ATOMIC_RELAXED, __HIP_MEMORY_SCOPE_AGENT) < target) { __builtin_amdgcn_s_sleep(2); if (++sp > (1u << 24)) break; } }
    __syncthreads();
}
DI void arrive_wait_wt(unsigned* cnt, const unsigned target) {
    asm volatile("s_waitcnt vmcnt(0)" ::: "memory");
    __syncthreads();
    if (threadIdx.x == 0) {
        (void)__hip_atomic_fetch_add(cnt, 1u, __ATOMIC_RELAXED, __HIP_MEMORY_SCOPE_AGENT);
        unsigned sp = 0; while (__hip_atomic_load(cnt, __ATOMIC_RELAXED, __HIP_MEMORY_SCOPE_AGENT) < target) { __builtin_amdgcn_s_sleep(1); if (++sp > (1u << 24)) break; }
    }
    __syncthreads();
}
DI void publish_counter_wt(unsigned* cnt) {
    asm volatile("s_waitcnt vmcnt(0)" ::: "memory");
    __syncthreads();
    if (threadIdx.x == 0) (void)__hip_atomic_fetch_add(cnt, 1u, __ATOMIC_RELAXED, __HIP_MEMORY_SCOPE_AGENT);
}

DI unsigned arrive_counter(unsigned* cnt, const unsigned target, const bool wait) {
    unsigned old = 0;
    asm volatile("s_waitcnt vmcnt(0)" ::: "memory");
    __syncthreads();
    if (threadIdx.x == 0) {
        __builtin_amdgcn_fence(__ATOMIC_RELEASE, "agent");
        asm volatile("s_waitcnt vmcnt(0)" ::: "memory");
        old = __hip_atomic_fetch_add(cnt, 1u, __ATOMIC_RELAXED, __HIP_MEMORY_SCOPE_AGENT);
        if (wait) { unsigned sp = 0; while (__hip_atomic_load(cnt, __ATOMIC_RELAXED, __HIP_MEMORY_SCOPE_AGENT) < target) { __builtin_amdgcn_s_sleep(1); if (++sp > (1u << 24)) break; } }
        __builtin_amdgcn_fence(__ATOMIC_ACQUIRE, "agent");
        asm volatile("s_waitcnt vmcnt(0)" ::: "memory");
    }
    __syncthreads();
    return old;
}

DI void epi_ln(f32x4 (&acc)[2][2][4][2], const Ctx& cx, const int layer, const int brow, const int bcol, const int pm, const int pn, unsigned char* lds) {
    const int et = otid(); const int ewr = et >> 8, ewc = (et >> 6) & 3, efr = et & 15, efq = (et >> 4) & 3;
    float* sred = (float*)lds;
    float* sstat = (float*)(lds + 135168);
    float* sg = (float*)(lds + 16384);
#pragma unroll
    for (int ai = 0; ai < 2; ++ai)
#pragma unroll
      for (int m = 0; m < 4; ++m) {
        const int row = brow + ai * HALF + ewr * 64 + m * 16 + efr;
        const float* rs = (layer == 0) ? cx.x_prompt + (size_t)row * D : cx.out + (size_t)row * D;
        float s = 0.f, q = 0.f;
#pragma unroll
        for (int bj = 0; bj < 2; ++bj)
#pragma unroll
          for (int n = 0; n < 2; ++n) {
            const int col = bcol + bj * HALF + ewc * 32 + n * 16 + efq * 4;
            const float4 xr = *(const float4*)(rs + col);
            f32x4 v = acc[ai][bj][m][n];
            v[0] = ALPHA * xr.x + v[0]; v[1] = ALPHA * xr.y + v[1]; v[2] = ALPHA * xr.z + v[2]; v[3] = ALPHA * xr.w + v[3];
            acc[ai][bj][m][n] = v;
            s += v[0] + v[1] + v[2] + v[3]; q += v[0] * v[0] + v[1] * v[1] + v[2] * v[2] + v[3] * v[3];
          }
        s += __shfl_xor(s, 16); s += __shfl_xor(s, 32); q += __shfl_xor(q, 16); q += __shfl_xor(q, 32);
        if (efq == 0) { const int rt = ai * HALF + ewr * 64 + m * 16 + efr; sred[(ewc * 256 + rt) * 2] = s; sred[(ewc * 256 + rt) * 2 + 1] = q; }
      }
    __syncthreads();
    if (et < 256) { float ps = 0.f, pq = 0.f;
#pragma unroll
        for (int w = 0; w < 4; ++w) { ps += sred[(w * 256 + et) * 2]; pq += sred[(w * 256 + et) * 2 + 1]; }
        uint2 pv; pv.x = __float_as_uint(ps); pv.y = __float_as_uint(pq); st_wt8(cx.STATP + ((size_t)(brow + et) * 8 + pn) * 2, pv); }
    arrive_wait_wt(cx.PANEL + layer * 32 + pm, 8u);
    if (et < 256) { const float* p = cx.STATP + (size_t)(brow + et) * 16;
        uint2 t8[8];
#pragma unroll
        for (int k = 0; k < 8; ++k) t8[k] = ld_wt8(p + k * 2);
        const float ssum = ((__uint_as_float(t8[0].x) + __uint_as_float(t8[1].x)) + (__uint_as_float(t8[2].x) + __uint_as_float(t8[3].x))) + ((__uint_as_float(t8[4].x) + __uint_as_float(t8[5].x)) + (__uint_as_float(t8[6].x) + __uint_as_float(t8[7].x)));
        const float qsum = ((__uint_as_float(t8[0].y) + __uint_as_float(t8[1].y)) + (__uint_as_float(t8[2].y) + __uint_as_float(t8[3].y))) + ((__uint_as_float(t8[4].y) + __uint_as_float(t8[5].y)) + (__uint_as_float(t8[6].y) + __uint_as_float(t8[7].y)));
        const float mu = ssum * (1.f / 2048.f);
        sstat[et * 2] = mu; sstat[et * 2 + 1] = rsqrtf(fmaxf(qsum * (1.f / 2048.f) - mu * mu, 0.f) + LN_EPS); }
    __syncthreads();
    float4 g4[2][2], b4[2][2];
#pragma unroll
    for (int bj = 0; bj < 2; ++bj)
#pragma unroll
      for (int n = 0; n < 2; ++n) { const int col = bcol + bj * HALF + ewc * 32 + n * 16 + efq * 4;
          g4[bj][n] = *(const float4*)(cx.ln_g + layer * D + col); b4[bj][n] = *(const float4*)(cx.ln_b + layer * D + col); }
    float* tf = (float*)lds;
    const int elane = et & 63, ewave = et >> 6;
#pragma unroll
    for (int ai = 0; ai < 2; ++ai) {
#pragma unroll
      for (int m = 0; m < 4; ++m) {
        const int rt = ai * HALF + ewr * 64 + m * 16 + efr; const float mu = sstat[rt * 2], rs_ = sstat[rt * 2 + 1];
#pragma unroll
        for (int bj = 0; bj < 2; ++bj)
#pragma unroll
          for (int n = 0; n < 2; ++n) {
            f32x4 v = acc[ai][bj][m][n];
            v[0] = (v[0] - mu) * rs_ * g4[bj][n].x + b4[bj][n].x; v[1] = (v[1] - mu) * rs_ * g4[bj][n].y + b4[bj][n].y;
            v[2] = (v[2] - mu) * rs_ * g4[bj][n].z + b4[bj][n].z; v[3] = (v[3] - mu) * rs_ * g4[bj][n].w + b4[bj][n].w;
            acc[ai][bj][m][n] = v;
            *(float4*)(tf + (ewr * 64 + m * 16 + efr) * 260 + bj * HALF + ewc * 32 + n * 16 + efq * 4) = make_float4(v[0], v[1], v[2], v[3]);
          }
      }
      __syncthreads();
#pragma unroll 4
      for (int r = 0; r < 16; ++r) { const int rr = ewave * 16 + r; const size_t grow = (size_t)(brow + ai * HALF + rr);
          const float4 v = *(const float4*)(tf + rr * 260 + elane * 4);
          *(float4*)(cx.out + grow * D + bcol + elane * 4) = v;
          if (layer == 0) { uint2 o; o.x = pack2(v.x, v.y); o.y = pack2(v.z, v.w); *(uint2*)(cx.XB + grow * D + bcol + elane * 4) = o; } }
      __syncthreads();
    }
    if (layer == 0) {
#pragma unroll 1
        for (int jg = 0; jg < 8; ++jg) {
            float4 w4[2][2];
#pragma unroll
            for (int bj = 0; bj < 2; ++bj)
#pragma unroll
              for (int n = 0; n < 2; ++n) w4[bj][n] = *(const float4*)(cx.GW + (size_t)(8 + jg) * 2048 + bcol + bj * HALF + ewc * 32 + n * 16 + efq * 4);
#pragma unroll
            for (int ai = 0; ai < 2; ++ai)
#pragma unroll
              for (int m = 0; m < 4; ++m) { float p = 0.f;
#pragma unroll
                for (int bj = 0; bj < 2; ++bj)
#pragma unroll
                  for (int n = 0; n < 2; ++n) { const f32x4 v = acc[ai][bj][m][n]; p += v[0] * w4[bj][n].x + v[1] * w4[bj][n].y + v[2] * w4[bj][n].z + v[3] * w4[bj][n].w; }
                p += __shfl_xor(p, 16); p += __shfl_xor(p, 32);
                if (efq == 0) { const int rt = ai * HALF + ewr * 64 + m * 16 + efr; sg[(ewc * 256 + rt) * 8 + jg] = p; } }
        }
        __syncthreads();
        if (et < 256) { float o8[8];
#pragma unroll
            for (int jg = 0; jg < 8; ++jg) o8[jg] = (sg[(0 * 256 + et) * 8 + jg] + sg[(1 * 256 + et) * 8 + jg]) + (sg[(2 * 256 + et) * 8 + jg] + sg[(3 * 256 + et) * 8 + jg]);
            float4* gp = (float4*)(cx.GPART + ((size_t)(brow + et) * 8 + pn) * 8);
            gp[0] = make_float4(o8[0], o8[1], o8[2], o8[3]); gp[1] = make_float4(o8[4], o8[5], o8[6], o8[7]); }
    }
    __syncthreads();
}

DI void sample_ln(const Ctx& c, const int l) {
    const int tid = otid(), lane = tid & 63, wave = __builtin_amdgcn_readfirstlane(tid >> 6);
    for (int k = 0; k < 4; ++k) {
        const int row = TP + wave * 4 + k;
        float4 v[8];
#pragma unroll
        for (int i = 0; i < 8; ++i) v[i] = *(const float4*)(c.out + (size_t)row * D + i * 256 + lane * 4);
        float s = 0.f;
#pragma unroll
        for (int i = 0; i < 8; ++i) s += v[i].x + v[i].y + v[i].z + v[i].w;
        const float mu = wave_sum(s) * (1.f / 2048.f);
        float q = 0.f;
#pragma unroll
        for (int i = 0; i < 8; ++i) { float a = v[i].x - mu, b = v[i].y - mu, cc = v[i].z - mu, d = v[i].w - mu; q += a * a + b * b + cc * cc + d * d; }
        const float rstd = rsqrtf(wave_sum(q) * (1.f / 2048.f) + LN_EPS);
        float ga[8];
#pragma unroll
        for (int j = 0; j < 8; ++j) ga[j] = 0.f;
#pragma unroll
        for (int i = 0; i < 8; ++i) {
            const float4 gg = *(const float4*)(c.ln_g + l * D + i * 256 + lane * 4), be = *(const float4*)(c.ln_b + l * D + i * 256 + lane * 4);
            v[i].x = (v[i].x - mu) * rstd * gg.x + be.x; v[i].y = (v[i].y - mu) * rstd * gg.y + be.y;
            v[i].z = (v[i].z - mu) * rstd * gg.z + be.z; v[i].w = (v[i].w - mu) * rstd * gg.w + be.w;
            *(float4*)(c.out + (size_t)row * D + i * 256 + lane * 4) = v[i];
            if (l == 0) {
                uint2 o; o.x = pack2(v[i].x, v[i].y); o.y = pack2(v[i].z, v[i].w);
                *(uint2*)(c.XB + (size_t)row * D + i * 256 + lane * 4) = o;
#pragma unroll
                for (int j = 0; j < 8; ++j) { const float4 ww = *(const float4*)(c.GW + (size_t)(8 + j) * 2048 + i * 256 + lane * 4);
                    ga[j] += v[i].x * ww.x + v[i].y * ww.y + v[i].z * ww.z + v[i].w * ww.w; }
            }
        }
        if (l == 0) {
#pragma unroll
            for (int j = 0; j < 8; ++j) ga[j] = wave_sum(ga[j]);
            if (lane < 4) {
                float gi = ga[0], gf = ga[4];
                if (lane == 1) { gi = ga[1]; gf = ga[5]; } else if (lane == 2) { gi = ga[2]; gf = ga[6]; } else if (lane == 3) { gi = ga[3]; gf = ga[7]; }
                c.GIG[row * 4 + lane] = gi + c.b_i[4 + lane];
                const float z = gf + c.b_f[4 + lane];
                c.GLF[row * 4 + lane] = fminf(z, 0.f) - __logf(1.f + __expf(-fabsf(z)));
            }
        }
    }
}

DI int lds_byte(int r, int c) {
    int st = (r >> 4) * 2 + (c >> 5), rr = r & 15, cc = c & 31, ob = rr * 64 + cc * 2;
    return st * 1024 + (ob ^ (((ob >> 9) & 1) << 5));
}
DI void stage_rc(int b, int& R, int& C) {
    int st = b / 1024, sb = b % 1024, swz = sb ^ (((sb >> 9) & 1) << 5);
    R = (st >> 1) * 16 + swz / 64; C = (st & 1) * 32 + (swz % 64) / 2;
}

template <int EPI>
DI void gemm_phase(const u16* __restrict__ A, const u16* __restrict__ Bt, const int nM, const int nN, const Ctx& cx, const int layer, unsigned char* lds) {
    u16* shm = (u16*)lds;
#define SA(b, h) (shm + ((b) * 2 + (h)) * HT)
#define SB(b, h) (shm + (4 + (b) * 2 + (h)) * HT)
#define STAGE(P, BASE, br, kt) do { const char* _gb = (const char*)((BASE) + (long)(br) * GK + (long)(kt) * BK); \
    for (int _i = 0; _i < 2; ++_i) { int _b = gtid * 16 + _i * 8192; unsigned _o = _i ? soff1 : soff0; asm volatile("" : "+v"(_o)); \
      __builtin_amdgcn_global_load_lds((const unsigned*)(_gb + _o), (unsigned*)((char*)(P) + _b), 16, 0, 0); } } while (0)
#define LDA(dst, b, h) for (int m = 0; m < 4; ++m) for (int k = 0; k < 2; ++k) \
    dst[m][k] = *reinterpret_cast<const bf16x8*>((char*)SA(b, h) + lds_byte(wr * 64 + m * 16 + fr, k * 32 + fq * 8))
#define LDB(dst, b, h) for (int n = 0; n < 2; ++n) for (int k = 0; k < 2; ++k) \
    dst[n][k] = *reinterpret_cast<const bf16x8*>((char*)SB(b, h) + lds_byte(wc * 32 + n * 16 + fr, k * 32 + fq * 8))
#define MMA(ai, bj, At, Btt) do { __builtin_amdgcn_s_setprio(1); \
    for (int m = 0; m < 4; ++m) for (int n = 0; n < 2; ++n) for (int k = 0; k < 2; ++k) \
      acc[ai][bj][m][n] = __builtin_amdgcn_mfma_f32_16x16x32_bf16(Btt[n][k], At[m][k], acc[ai][bj][m][n], 0, 0, 0); \
    __builtin_amdgcn_s_setprio(0); } while (0)
#define WAIT_V(n) asm volatile("s_waitcnt vmcnt(" #n ")" ::: "memory")
#define WAIT_L(n) asm volatile("s_waitcnt lgkmcnt(" #n ")" ::: "memory")
#define BAR __builtin_amdgcn_s_barrier()
#define SCHED __builtin_amdgcn_sched_barrier(0)
    const int nwg = nM * nN; const int gtid = otid();
    const int wid = gtid >> 6, lane = gtid & 63, wr = wid >> 2, wc = wid & 3, fr = lane & 15, fq = lane >> 4;
    unsigned soff0, soff1;
    { int r, c2; stage_rc(gtid * 16, r, c2); soff0 = (unsigned)(r * GK + c2) * 2u; stage_rc(gtid * 16 + 8192, r, c2); soff1 = (unsigned)(r * GK + c2) * 2u; }
    constexpr int nt = GK / BK;
    for (int tile = blockIdx.x; tile < nwg; tile += gridDim.x) {
        int wgid = tile;
        { int q = nwg / NXCD, r = nwg % NXCD, xcd = wgid % NXCD, off = wgid / NXCD;
          wgid = (xcd < r ? xcd * (q + 1) : r * (q + 1) + (xcd - r) * q) + off; }
        const int nig = WGM * nN, gid = wgid / nig, fm = gid * WGM, gsz = min(nM - fm, WGM);
        const int pm = fm + ((wgid % nig) % gsz), pn = (wgid % nig) / gsz, brow = pm * BM, bcol = pn * BM;
        f32x4 acc[2][2][4][2];
        for (int a = 0; a < 2; ++a) for (int b = 0; b < 2; ++b) for (int m = 0; m < 4; ++m) for (int n = 0; n < 2; ++n) acc[a][b][m][n] = (f32x4){0.f, 0.f, 0.f, 0.f};
        bf16x8 At[4][2], B0[2][2], B1[2][2];
#if SAFE_GEMM
        for (int t = 0; t < nt; ++t) {
            STAGE(SB(0, 0), Bt, bcol, t); STAGE(SA(0, 0), A, brow, t); STAGE(SB(0, 1), Bt, bcol + HALF, t); STAGE(SA(0, 1), A, brow + HALF, t);
            WAIT_V(0); __syncthreads();
            LDB(B0, 0, 0); LDB(B1, 0, 1); LDA(At, 0, 0); WAIT_L(0);
            MMA(0, 0, At, B0); MMA(0, 1, At, B1);
            LDA(At, 0, 1); WAIT_L(0);
            MMA(1, 0, At, B0); MMA(1, 1, At, B1);
            __syncthreads();
        }
#else
        STAGE(SB(0, 0), Bt, bcol, 0); STAGE(SA(0, 0), A, brow, 0);
        STAGE(SB(0, 1), Bt, bcol + HALF, 0); STAGE(SA(0, 1), A, brow + HALF, 0);
        if (wr == 1) BAR;
        WAIT_V(4); BAR;
        STAGE(SB(1, 0), Bt, bcol, 1); STAGE(SA(1, 0), A, brow, 1); STAGE(SB(1, 1), Bt, bcol + HALF, 1);
        WAIT_V(6); BAR;
        for (int t = 0; t < nt - 2; t += 2) {
            LDB(B0, 0, 0); SCHED; LDA(At, 0, 0); STAGE(SA(1, 1), A, brow + HALF, t + 1);
            WAIT_L(8); BAR; WAIT_L(0); MMA(0, 0, At, B0); BAR; SCHED;
            LDB(B1, 0, 1); STAGE(SB(0, 0), Bt, bcol, t + 2);
            BAR; WAIT_L(0); MMA(0, 1, At, B1); BAR;
            LDA(At, 0, 1); STAGE(SA(0, 0), A, brow, t + 2);
            BAR; WAIT_L(0); MMA(1, 0, At, B0); BAR; SCHED;
            STAGE(SB(0, 1), Bt, bcol + HALF, t + 2);
            WAIT_V(6); BAR; MMA(1, 1, At, B1); BAR;
            LDB(B0, 1, 0); SCHED; LDA(At, 1, 0); STAGE(SA(0, 1), A, brow + HALF, t + 2);
            WAIT_L(8); BAR; WAIT_L(0); MMA(0, 0, At, B0); BAR; SCHED;
            LDB(B1, 1, 1); STAGE(SB(1, 0), Bt, bcol, t + 3);
            BAR; WAIT_L(0); MMA(0, 1, At, B1); BAR;
            LDA(At, 1, 1); STAGE(SA(1, 0), A, brow, t + 3);
            BAR; WAIT_L(0); MMA(1, 0, At, B0); BAR; SCHED;
            STAGE(SB(1, 1), Bt, bcol + HALF, t + 3);
            WAIT_V(6); BAR; MMA(1, 1, At, B1); BAR;
        }
        { LDB(B0, 0, 0); LDA(At, 0, 0); STAGE(SA(1, 1), A, brow + HALF, nt - 1);
          BAR; WAIT_L(0); MMA(0, 0, At, B0); BAR;
          LDB(B1, 0, 1); BAR; WAIT_L(0); MMA(0, 1, At, B1); BAR;
          LDA(At, 0, 1); WAIT_V(4); BAR; WAIT_L(0); MMA(1, 0, At, B0); MMA(1, 1, At, B1); BAR; }
        { LDB(B0, 1, 0); LDA(At, 1, 0); WAIT_V(2); BAR; WAIT_L(0); MMA(0, 0, At, B0); BAR;
          LDB(B1, 1, 1); WAIT_V(0); BAR; WAIT_L(0); MMA(0, 1, At, B1); BAR;
          LDA(At, 1, 1); BAR; WAIT_L(0); MMA(1, 0, At, B0); MMA(1, 1, At, B1); BAR; }
        if (wr == 0) BAR;
#endif
        if (EPI == 2) { epi_ln(acc, cx, layer, brow, bcol, pm, pn, lds); continue; }
        if (EPI == 0) {
            const int et = otid(); const int ewr = et >> 8, ewc = (et >> 6) & 3, efr = et & 15, efq = (et >> 4) & 3, elane = et & 63, ewave = et >> 6;
            u16* tl = (u16*)lds;
#pragma unroll
            for (int ai = 0; ai < 2; ++ai)
#pragma unroll
              for (int m = 0; m < 4; ++m)
#pragma unroll
                for (int bj = 0; bj < 2; ++bj)
#pragma unroll
                  for (int n = 0; n < 2; ++n) { const f32x4 v = acc[ai][bj][m][n];
                      uint2 o; o.x = pack2(v[0], v[1]); o.y = pack2(v[2], v[3]);
                      *(uint2*)(tl + (ai * HALF + ewr * 64 + m * 16 + efr) * 264 + bj * HALF + ewc * 32 + n * 16 + efq * 4) = o; }
            __syncthreads();
#pragma unroll 8
            for (int r = 0; r < 32; ++r) { const int row = ewave * 32 + r;
                *(uint2*)(cx.H + (size_t)(brow + row) * NH + bcol + elane * 4) = *(const uint2*)(tl + row * 264 + elane * 4); }
            __syncthreads();
            continue;
        }
        const int et = otid(); const int ewr = et >> 8, ewc = (et >> 6) & 3, efr = et & 15, efq = (et >> 4) & 3;
#pragma unroll
        for (int ai = 0; ai < 2; ++ai)
#pragma unroll
          for (int m = 0; m < 4; ++m) {
            const int row = brow + ai * HALF + ewr * 64 + m * 16 + efr;
#pragma unroll
            for (int bj = 0; bj < 2; ++bj)
#pragma unroll
              for (int n = 0; n < 2; ++n) {
                const int col = bcol + bj * HALF + ewc * 32 + n * 16 + efq * 4;
                const f32x4 v = acc[ai][bj][m][n];
                if (EPI == 0) {
                    uint2 o; o.x = pack2(v[0], v[1]); o.y = pack2(v[2], v[3]);
                    *(uint2*)(cx.H + (size_t)row * NH + col) = o;
                } else {
                    if (row < TT) {
                        const float* rs = (layer == 0) ? (row < TP ? cx.x_prompt + (size_t)row * D : cx.x_sample + (size_t)(row - TP) * D) : cx.out + (size_t)row * D;
                        const float4 xr = *(const float4*)(rs + col);
                        float4 o; o.x = ALPHA * xr.x + v[0]; o.y = ALPHA * xr.y + v[1]; o.z = ALPHA * xr.z + v[2]; o.w = ALPHA * xr.w + v[3];
                        *(float4*)(cx.out + (size_t)row * D + col) = o;
                    }
                }
            }
        }
    }
    WAIT_V(0);
    __syncthreads();
#undef SA
#undef SB
#undef STAGE
#undef LDA
#undef LDB
#undef MMA
}


DI void gemm2_sample_item(const Ctx& cx, const u16* __restrict__ Bt, const int layer, const int item, unsigned char* lds) {
    float* part = (float*)lds;
    const int tid = otid(), lane = tid & 63, wave = __builtin_amdgcn_readfirstlane(tid >> 6), fr = lane & 15, fq = lane >> 4;
    const int n0 = item * 64;
    f32x4 acc[2][4];
#pragma unroll
    for (int m = 0; m < 2; ++m)
#pragma unroll
        for (int n = 0; n < 4; ++n) acc[m][n] = (f32x4){0.f, 0.f, 0.f, 0.f};
    const u16* ap = cx.XB + (size_t)(TP + fr) * D + wave * 256 + fq * 8;
    const u16* bp = Bt + (size_t)(n0 + fr) * D + wave * 256 + fq * 8;
#pragma unroll
    for (int half = 0; half < 2; ++half) {
        bf16x8 af[2][4], bq[4][4];
#pragma unroll
        for (int ks = 0; ks < 4; ++ks) {
#pragma unroll
            for (int m = 0; m < 2; ++m) af[m][ks] = *(const bf16x8*)(ap + (size_t)m * 16 * D + (half * 4 + ks) * 32);
#pragma unroll
            for (int n = 0; n < 4; ++n) bq[n][ks] = *(const bf16x8*)(bp + (size_t)n * 16 * D + (half * 4 + ks) * 32);
        }
#pragma unroll
        for (int ks = 0; ks < 4; ++ks)
#pragma unroll
            for (int m = 0; m < 2; ++m)
#pragma unroll
                for (int n = 0; n < 4; ++n) acc[m][n] = mfma16(af[m][ks], bq[n][ks], acc[m][n]);
    }
#pragma unroll
    for (int m = 0; m < 2; ++m)
#pragma unroll
        for (int n = 0; n < 4; ++n) *(f32x4*)(part + ((wave * 8 + m * 4 + n) * 64 + lane) * 4) = acc[m][n];
    __syncthreads();
    { const int row = tid >> 4, col = (tid & 15) * 4;
      const int m = row >> 4, n = col >> 4, j = row & 3;
      float o[4];
#pragma unroll
      for (int i = 0; i < 4; ++i) { const int ln = ((row & 15) >> 2) * 16 + (col & 15) + i; float sacc = 0.f;
#pragma unroll
          for (int w = 0; w < 8; ++w) sacc += part[((w * 8 + m * 4 + n) * 64 + ln) * 4 + j];
          o[i] = sacc; }
      const float* rs = (layer == 0) ? cx.x_sample + (size_t)row * D : cx.out + (size_t)(TP + row) * D;
      const float4 xr = *(const float4*)(rs + n0 + col);
      float4 ov; ov.x = ALPHA * xr.x + o[0]; ov.y = ALPHA * xr.y + o[1]; ov.z = ALPHA * xr.z + o[2]; ov.w = ALPHA * xr.w + o[3];
      *(float4*)(cx.out + (size_t)(TP + row) * D + n0 + col) = ov; }
    { const unsigned old = arrive_counter(cx.SAMP + layer, 0u, false);
      unsigned* flag = (unsigned*)lds;
      if (threadIdx.x == 0) *flag = (old == 31u) ? 1u : 0u;
      __syncthreads();
      const bool last = (*flag != 0u);
      __syncthreads();
      if (last) sample_ln(cx, layer); }
    __syncthreads();
}

DI void transpose_item(const float* __restrict__ w, const int ldw, const int thresh, u16* __restrict__ Wt, const int item, const int ntile_n, unsigned char* lds) {
    float* tile = (float*)lds;
    const int tid = otid();
    const int kt = item / ntile_n, ntl = item % ntile_n, k0 = kt * 128, n0 = ntl * 128;
    const int ns0 = n0 + (n0 >= thresh ? 8 : 0);
    { const int n = tid & 127, kq = tid >> 7;
      float v[32];
#pragma unroll
      for (int i = 0; i < 32; ++i) v[i] = w[(size_t)(k0 + kq + 4 * i) * ldw + ns0 + n];
#pragma unroll
      for (int i = 0; i < 32; ++i) tile[(kq + 4 * i) * 129 + n] = v[i]; }
    __syncthreads();
    { const int k2 = (tid & 63) * 2, nq = tid >> 6;
#pragma unroll
      for (int i = 0; i < 16; ++i) { const int nn = nq + 8 * i;
        *(unsigned*)(Wt + (size_t)(n0 + nn) * 2048 + k0 + k2) = pack2(tile[k2 * 129 + nn], tile[(k2 + 1) * 129 + nn]); } }
    __syncthreads();
}

template <int MODE>
DI void row_phase(const Ctx& c, const int gate_layer, const int ln_layer, unsigned char* lds) {
    float* wg = (float*)lds;
    const int tid = otid(), lane = tid & 63, wave = __builtin_amdgcn_readfirstlane(tid >> 6);
    if (gate_layer >= 0) {
        const float* w = c.w_in + (size_t)gate_layer * D * DIN;
        for (int i = tid; i < 8 * 2048; i += 512) { const int k = i >> 3, j = i & 7; wg[j * 2048 + k] = w[(size_t)k * DIN + 4096 + j]; }
    }
    __syncthreads();
    const int rstep = gridDim.x * 8;
    float4 vn[8];
    { const int row = blockIdx.x * 8 + wave;
      if (row < TT) { const float* src = (MODE == 0) ? (row < TP ? c.x_prompt + (size_t)row * D : c.x_sample + (size_t)(row - TP) * D) : c.out + (size_t)row * D;
#pragma unroll
        for (int i = 0; i < 8; ++i) vn[i] = *(const float4*)(src + i * 256 + lane * 4); } }
    for (int row = blockIdx.x * 8 + wave; row < TT; row += rstep) {
        float4 v[8];
#pragma unroll
        for (int i = 0; i < 8; ++i) v[i] = vn[i];
        { const int nrow = row + rstep;
          if (nrow < TT) { const float* src = (MODE == 0) ? (nrow < TP ? c.x_prompt + (size_t)nrow * D : c.x_sample + (size_t)(nrow - TP) * D) : c.out + (size_t)nrow * D;
#pragma unroll
            for (int i = 0; i < 8; ++i) vn[i] = *(const float4*)(src + i * 256 + lane * 4); } }
        if (MODE == 1) {
            float s = 0.f;
#pragma unroll
            for (int i = 0; i < 8; ++i) s += v[i].x + v[i].y + v[i].z + v[i].w;
            const float mu = wave_sum(s) * (1.f / 2048.f);
            float q = 0.f;
#pragma unroll
            for (int i = 0; i < 8; ++i) { float a = v[i].x - mu, b = v[i].y - mu, cc = v[i].z - mu, d = v[i].w - mu; q += a * a + b * b + cc * cc + d * d; }
            const float rstd = rsqrtf(wave_sum(q) * (1.f / 2048.f) + LN_EPS);
            const float* g = c.ln_g + ln_layer * D; const float* bb = c.ln_b + ln_layer * D;
#pragma unroll
            for (int i = 0; i < 8; ++i) {
                const float4 gg = *(const float4*)(g + i * 256 + lane * 4), be = *(const float4*)(bb + i * 256 + lane * 4);
                v[i].x = (v[i].x - mu) * rstd * gg.x + be.x; v[i].y = (v[i].y - mu) * rstd * gg.y + be.y;
                v[i].z = (v[i].z - mu) * rstd * gg.z + be.z; v[i].w = (v[i].w - mu) * rstd * gg.w + be.w;
                *(float4*)(c.out + (size_t)row * D + i * 256 + lane * 4) = v[i];
            }
        }
        if (gate_layer >= 0) {
            float ga[8];
#pragma unroll
            for (int j = 0; j < 8; ++j) ga[j] = 0.f;
#pragma unroll
            for (int i = 0; i < 8; ++i) {
                uint2 o; o.x = pack2(v[i].x, v[i].y); o.y = pack2(v[i].z, v[i].w);
                *(uint2*)(c.XB + (size_t)row * D + i * 256 + lane * 4) = o;
#pragma unroll
                for (int j = 0; j < 8; ++j) { const float4 ww = *(const float4*)(wg + j * 2048 + i * 256 + lane * 4);
                    ga[j] += v[i].x * ww.x + v[i].y * ww.y + v[i].z * ww.z + v[i].w * ww.w; }
                asm volatile("" ::: "memory");
            }
#pragma unroll
            for (int j = 0; j < 8; ++j) ga[j] = wave_sum(ga[j]);
            if (lane < 4) {
                float gi = ga[0], gf = ga[4];
                if (lane == 1) { gi = ga[1]; gf = ga[5]; } else if (lane == 2) { gi = ga[2]; gf = ga[6]; } else if (lane == 3) { gi = ga[3]; gf = ga[7]; }
                c.GIG[row * 4 + lane] = gi + c.b_i[gate_layer * 4 + lane];
                const float z = gf + c.b_f[gate_layer * 4 + lane];
                c.GLF[row * 4 + lane] = fminf(z, 0.f) - __logf(1.f + __expf(-fabsf(z)));
            }
        }
    }
    __syncthreads();
}

DI void m1_item(const Ctx& c, const int unit, unsigned char* lds, const int mode = 0) {
    u16* sKt = (u16*)lds; u16* sVt = (u16*)(lds + 69632); float* fl = (float*)(lds + 139264);
    float *s_lf = fl, *s_ig = fl + 128, *s_gl = fl + 256;
    const int tid = otid(), lane = tid & 63, wave = __builtin_amdgcn_readfirstlane(tid >> 6), fr = lane & 15, fq = lane >> 4;
    const int b = unit >> 7, h = (unit >> 5) & 3, ch = unit & 31, rb = b * 4096 + ch * 128;
    if (tid < 128) { s_lf[tid] = c.GLF[(rb + tid) * 4 + h]; s_ig[tid] = c.GIG[(rb + tid) * 4 + h]; }
    bf16x8 kvr[8], vvr[8];
    { const int sl = wave * 8 + (lane & 7), dch = lane >> 3;
#pragma unroll
      for (int i = 0; i < 8; ++i) { const size_t ro = (size_t)(rb + sl + 64 * (i & 1)) * NH + h * 256 + (i >> 1) * 64 + dch * 8;
          kvr[i] = *(const bf16x8*)(c.H + ro + HK); vvr[i] = *(const bf16x8*)(c.H + ro + HV); } }
    __syncthreads();
    if (wave == 0) {
        const float x0 = s_lf[2 * lane], x1 = s_lf[2 * lane + 1]; const float loc = x0 + x1; float inc = loc;
        for (int o = 1; o < 64; o <<= 1) { const float y = __shfl_up(inc, o); if (lane >= o) inc += y; }
        const float ex = inc - loc, b0 = ex + x0, b1 = ex + loc;
        const float Btot = __int_as_float(__builtin_amdgcn_readlane(__float_as_int(inc), 63));
        const float l0 = Btot - b0 + s_ig[2 * lane], l1 = Btot - b1 + s_ig[2 * lane + 1];
        const float a = wave_max(fmaxf(l0, l1));
        s_gl[2 * lane] = __expf(l0 - a) * 0.0625f; s_gl[2 * lane + 1] = __expf(l1 - a) * 0.0625f;
        if (lane == 0) { st_wt4(c.AB + unit * 2, a); st_wt4(c.AB + unit * 2 + 1, Btot); }
    }
    __syncthreads();
    { const int sl = wave * 8 + (lane & 7), dch = lane >> 3;
#pragma unroll
      for (int i = 0; i < 8; ++i) { const int s = sl + 64 * (i & 1); const float g = s_gl[s]; const int pc = s ^ (dch << 3);
          const bf16x8 kv = kvr[i]; const bf16x8 vv = vvr[i];
#pragma unroll
        for (int e = 0; e < 8; ++e) { const int dd = (i >> 1) * 64 + dch * 8 + e; sKt[dd * 136 + pc] = f2bf(bf2f((u16)kv[e]) * g); sVt[dd * 136 + pc] = (u16)vv[e]; } } }
    __syncthreads();
    if (mode == 1) { __syncthreads(); return; }
    f32x4 acc[2][16];
#pragma unroll
    for (int m = 0; m < 2; ++m)
#pragma unroll
        for (int et = 0; et < 16; ++et) acc[m][et] = (f32x4){0.f, 0.f, 0.f, 0.f};
#pragma unroll
    for (int kk = 0; kk < 4; ++kk) {
        const int gx = (kk * 4 + fq) ^ ((fr >> 3) & 1);
        const int r0 = wave * 32 + fr, r1 = wave * 32 + 16 + fr;
        const bf16x8 a0 = *(const bf16x8*)&sKt[r0 * 136 + (((kk * 4 + fq) ^ ((r0 >> 3) & 7)) << 3)];
        const bf16x8 a1 = *(const bf16x8*)&sKt[r1 * 136 + (((kk * 4 + fq) ^ ((r1 >> 3) & 7)) << 3)];
        (void)gx;
#pragma unroll
        for (int eg = 0; eg < 16; eg += 8) { bf16x8 bv[8];
#pragma unroll
            for (int k = 0; k < 8; ++k) { const int re = (eg + k) * 16 + fr; bv[k] = *(const bf16x8*)&sVt[re * 136 + (((kk * 4 + fq) ^ ((re >> 3) & 7)) << 3)]; }
            PIN8(bv);
#pragma unroll
            for (int k = 0; k < 8; ++k) { acc[0][eg + k] = mfma16(a0, bv[k], acc[0][eg + k]); acc[1][eg + k] = mfma16(a1, bv[k], acc[1][eg + k]); } }
    }
    if (mode == 2) { float sink_ = 0.f;
#pragma unroll
        for (int m = 0; m < 2; ++m)
#pragma unroll
            for (int et = 0; et < 16; ++et) sink_ += acc[m][et][0] + acc[m][et][1] + acc[m][et][2] + acc[m][et][3];
        if (sink_ == 1.2345e-30f) c.AB[600] = sink_;
        __syncthreads(); return; }
    if (tid < 256) { float sdn = 0.f;
#pragma unroll
        for (int i = 0; i < 16; ++i) { const bf16x8 v = *(const bf16x8*)&sKt[tid * 136 + i * 8];
#pragma unroll
            for (int e = 0; e < 8; ++e) sdn += bf2f((u16)v[e]); }
        st_wt4(c.DN + unit * 256 + tid, sdn); }
    __syncthreads();
    u16* tileC = (u16*)lds;
#pragma unroll
    for (int m = 0; m < 2; ++m)
#pragma unroll
        for (int et = 0; et < 16; ++et) { const int e = et * 16 + fr, d0 = wave * 32 + m * 16 + fq * 4; const f32x4 v = acc[m][et];
            uint2 o; o.x = pack2(v[0], v[1]); o.y = pack2(v[2], v[3]); *(uint2*)(tileC + e * 264 + d0) = o; }
    __syncthreads();
    { u16* cs = c.CS + (size_t)unit * 65536;
#pragma unroll 8
      for (int r = 0; r < 32; ++r) { const int e = wave * 32 + r; st_wt8(cs + e * 256 + lane * 4, *(const uint2*)(tileC + e * 264 + lane * 4)); } }
    __syncthreads();
}

DI void scan_item(const Ctx& c, const int l, const int item, unsigned char* lds) {
    float* sa = (float*)lds; float* tileT = (float*)(lds + 1024);
    const int tid = otid(), bh = item >> 5, part = item & 31;
    if (tid < 32) { sa[tid] = ld_wt4(c.AB + (bh * 32 + tid) * 2); sa[32 + tid] = ld_wt4(c.AB + (bh * 32 + tid) * 2 + 1); }
    __syncthreads();
    if (tid == 0) { float m = 0.f;
        for (int ch = 0; ch < 32; ++ch) { const float a = sa[ch], B = sa[32 + ch]; const float me = fmaxf(B + m, a);
            sa[64 + ch] = __expf(B + m - me); sa[96 + ch] = __expf(a - me); sa[128 + ch] = m; m = me; }
        sa[160] = m; }
    __syncthreads();
    if (part == 0 && tid < 32) st_wt4(c.M0 + bh * 32 + tid, sa[128 + tid]);
    const u16* p = c.CS + (size_t)bh * 32 * 65536 + (size_t)part * 2048 + tid * 4;
    u16* p2 = c.CS2 + (size_t)bh * 32 * 65536 + (size_t)part * 2048 + tid * 4;
    float c0 = 0.f, c1 = 0.f, c2 = 0.f, c3 = 0.f;
    asm volatile("" : "+v"(c0), "+v"(c1), "+v"(c2), "+v"(c3));
    for (int cg8 = 0; cg8 < 32; cg8 += 8) {
        uint2 raw[8];
#pragma unroll
        for (int k = 0; k < 8; ++k) raw[k] = ld_wt8(p + (size_t)(cg8 + k) * 65536);
#pragma unroll
        for (int k = 0; k < 8; ++k) { const int ch = cg8 + k;
            uint2 o; o.x = pack2(c0, c1); o.y = pack2(c2, c3);
            st_wt8(p2 + (size_t)ch * 65536, o);
            const float g0 = sa[64 + ch], gs = sa[96 + ch];
            c0 = g0 * c0 + gs * bf2f((u16)(raw[k].x & 0xffff)); c1 = g0 * c1 + gs * bf2f((u16)(raw[k].x >> 16));
            c2 = g0 * c2 + gs * bf2f((u16)(raw[k].y & 0xffff)); c3 = g0 * c3 + gs * bf2f((u16)(raw[k].y >> 16)); }
    }
    { const int e_loc = tid >> 6, d = (tid & 63) * 4;
      tileT[(d + 0) * 8 + e_loc] = c0; tileT[(d + 1) * 8 + e_loc] = c1; tileT[(d + 2) * 8 + e_loc] = c2; tileT[(d + 3) * 8 + e_loc] = c3; }
    __syncthreads();
    { const int d = tid >> 1, e4 = (tid & 1) * 4;
      *(float4*)(c.out + O_CP + (size_t)(l * 8 + bh) * 65536 + d * 256 + part * 8 + e4) = *(const float4*)(tileT + d * 8 + e4); }
    if (part == 0 && tid < 256) {
        float nn = 0.f;
        float dnr[32];
#pragma unroll
        for (int ch = 0; ch < 32; ++ch) dnr[ch] = ld_wt4(c.DN + (bh * 32 + ch) * 256 + tid);
#pragma unroll
        for (int ch = 0; ch < 32; ++ch) { st_wt4(c.N0 + (bh * 32 + ch) * 256 + tid, nn); nn = sa[64 + ch] * nn + sa[96 + ch] * dnr[ch]; }
        c.out[O_NP + (l * 8 + bh) * 256 + tid] = nn;
        if (tid == 0) c.out[O_MP + l * 8 + bh] = sa[160];
    }
    __syncthreads();
}

DI void m3_item(const Ctx& c, const int l, const int unit, unsigned char* lds) {
    u16* sVt = (u16*)lds; u16* sP = (u16*)(lds + 69632); float* fl = (float*)(lds + 104448);
    float *s_lf = fl, *s_ig = fl + 128, *s_u = fl + 256, *s_M = fl + 384, *s_w0 = fl + 512, *s_emm = fl + 640, *s_qn = fl + 768, *s_rinv = fl + 896, *s_n0 = fl + 1024;
    const int tid = otid(), lane = tid & 63, wave = __builtin_amdgcn_readfirstlane(tid >> 6), fr = lane & 15, fq = lane >> 4;
    const int b = unit >> 7, h = (unit >> 5) & 3, ch = unit & 31, rb = b * 4096 + ch * 128;
    if (tid < 128) { s_lf[tid] = c.GLF[(rb + tid) * 4 + h]; s_ig[tid] = c.GIG[(rb + tid) * 4 + h]; }
    if (tid >= 256) s_n0[tid - 256] = ld_wt4(c.N0 + unit * 256 + tid - 256);
    const float m0 = ld_wt4(c.M0 + unit);
    __syncthreads();
    if (wave == 0) {
        const float x0 = s_lf[2 * lane], x1 = s_lf[2 * lane + 1]; const float loc = x0 + x1; float inc = loc;
        for (int o = 1; o < 64; o <<= 1) { const float y = __shfl_up(inc, o); if (lane >= o) inc += y; }
        const float ex = inc - loc, b0 = ex + x0, b1 = ex + loc;
        const float u0 = s_ig[2 * lane] - b0, u1 = s_ig[2 * lane + 1] - b1;
        float mx = fmaxf(u0, u1);
        for (int o = 1; o < 64; o <<= 1) { const float y = __shfl_up(mx, o); if (lane >= o) mx = fmaxf(mx, y); }
        float mprev = __shfl_up(mx, 1); if (lane == 0) mprev = -3.0e38f;
        const float M0v = fmaxf(m0, fmaxf(mprev, u0)), M1v = fmaxf(m0, mx);
        s_u[2 * lane] = u0; s_u[2 * lane + 1] = u1; s_M[2 * lane] = M0v; s_M[2 * lane + 1] = M1v;
        s_w0[2 * lane] = __expf(m0 - M0v); s_w0[2 * lane + 1] = __expf(m0 - M1v);
        s_emm[2 * lane] = __expf(-(b0 + M0v)); s_emm[2 * lane + 1] = __expf(-(b1 + M1v));
    }
    u16* sK = (u16*)lds;
    bf16x8 vvr[8];
    { const int krow = tid >> 5, kcol = (tid & 31) * 8;
      bf16x8 kk[8];
#pragma unroll
      for (int p = 0; p < 8; ++p) kk[p] = *(const bf16x8*)(c.H + (size_t)(rb + p * 16 + krow) * NH + HK + h * 256 + kcol);
      const u16* vp = c.H + (size_t)(rb + (tid & 127)) * NH + HV + h * 256 + (tid >> 7) * 64;
#pragma unroll
      for (int i = 0; i < 8; ++i) vvr[i] = *(const bf16x8*)(vp + i * 8);
#pragma unroll
      for (int p = 0; p < 8; ++p) *(bf16x8*)(sK + (p * 16 + krow) * 264 + kcol) = kk[p]; }
    { const int t = tid >> 2, qt = tid & 3; const u16* qp = c.H + (size_t)(rb + t) * NH + HQ + h * 256 + qt * 64; float s = 0.f;
#pragma unroll
      for (int i = 0; i < 8; ++i) { const bf16x8 qv = *(const bf16x8*)(qp + i * 8);
#pragma unroll
        for (int e = 0; e < 8; ++e) s += bf2f((u16)qv[e]) * s_n0[qt * 64 + i * 8 + e]; }
      s += __shfl_xor(s, 1); s += __shfl_xor(s, 2);
      if (qt == 0) s_qn[t] = s; }
    __syncthreads();
    bf16x8 qf[8];
    { const u16* qp = c.H + (size_t)(rb + wave * 16 + fr) * NH + HQ + h * 256 + fq * 8;
#pragma unroll
      for (int ks = 0; ks < 8; ++ks) qf[ks] = *(const bf16x8*)(qp + ks * 32); }
    const int nks = (wave >> 1) + 1;
    for (int js = 0; js < 2 * nks; ++js) {
        f32x4 a = (f32x4){0.f, 0.f, 0.f, 0.f};
        if (js <= wave) { bf16x8 kf[8];
#pragma unroll
            for (int ks = 0; ks < 8; ++ks) kf[ks] = *(const bf16x8*)(sK + (js * 16 + fr) * 264 + ks * 32 + fq * 8);
            PIN8(kf);
#pragma unroll
            for (int ks = 0; ks < 8; ++ks) a = mfma16(qf[ks], kf[ks], a); }
        const int si = js * 16 + fr; const float us = s_u[si];
#pragma unroll
        for (int j = 0; j < 4; ++j) { const int ti = wave * 16 + fq * 4 + j;
            const float val = (si <= ti) ? a[j] * 0.0625f * __expf(us - s_M[ti]) : 0.f;
            sP[ti * 136 + si] = f2bf(val); }
    }
    __syncthreads();
    { const int s2 = tid & 127, grp = tid >> 7;
#pragma unroll
      for (int i = 0; i < 8; ++i) { const bf16x8 vv = vvr[i];
#pragma unroll
        for (int e = 0; e < 8; ++e) sVt[(grp * 64 + i * 8 + e) * 136 + s2] = (u16)vv[e]; } }
    { const int tl = lane & 15, part = lane >> 4; float s = 0.f;
      if (part < nks) { const u16* pp = sP + (wave * 16 + tl) * 136 + part * 32;
#pragma unroll
        for (int i = 0; i < 4; ++i) { const bf16x8 v = *(const bf16x8*)(pp + i * 8);
#pragma unroll
          for (int e = 0; e < 8; ++e) s += bf2f((u16)v[e]); } }
      s += __shfl_xor(s, 16); s += __shfl_xor(s, 32);
      const int t = wave * 16 + tl;
      if (part == 0) { const float den = s + s_w0[t] * s_qn[t]; s_rinv[t] = 1.f / fmaxf(fabsf(den), s_emm[t]); } }
    __syncthreads();
    f32x4 acc[16];
#pragma unroll
    for (int et = 0; et < 16; ++et) acc[et] = (f32x4){0.f, 0.f, 0.f, 0.f};
    {
      u16* cq = (u16*)(lds + 109568);
      const u16* cs = c.CS2 + (size_t)unit * 65536;
      const int crow = tid >> 5, ccol = (tid & 31) * 8;
      bf16x8 pre[4];
#pragma unroll
      for (int p = 0; p < 4; ++p) { const u16* gp = cs + (size_t)(p * 16 + crow) * 256 + ccol; const uint2 lo = ld_wt8(gp), hi = ld_wt8(gp + 4); uint4 q4 = make_uint4(lo.x, lo.y, hi.x, hi.y); pre[p] = __builtin_bit_cast(bf16x8, q4); }
#pragma unroll
      for (int q = 0; q < 4; ++q) {
#pragma unroll
          for (int p = 0; p < 4; ++p) *(bf16x8*)(cq + (p * 16 + crow) * 264 + ccol) = pre[p];
          if (q < 3) {
#pragma unroll
              for (int p = 0; p < 4; ++p) { const u16* gp = cs + (size_t)((q + 1) * 64 + p * 16 + crow) * 256 + ccol; const uint2 lo = ld_wt8(gp), hi = ld_wt8(gp + 4); uint4 q4 = make_uint4(lo.x, lo.y, hi.x, hi.y); pre[p] = __builtin_bit_cast(bf16x8, q4); }
          }
          __syncthreads();
#pragma unroll
          for (int t4 = 0; t4 < 4; ++t4) { const int et = q * 4 + t4; bf16x8 cf[8];
#pragma unroll
              for (int ks = 0; ks < 8; ++ks) cf[ks] = *(const bf16x8*)(cq + (t4 * 16 + fr) * 264 + ks * 32 + fq * 8);
              PIN8(cf);
#pragma unroll
              for (int ks = 0; ks < 8; ++ks) acc[et] = mfma16(qf[ks], cf[ks], acc[et]); }
          __syncthreads();
      } }
    float w0r[4], rinv[4];
#pragma unroll
    for (int j = 0; j < 4; ++j) { w0r[j] = s_w0[wave * 16 + fq * 4 + j]; rinv[j] = s_rinv[wave * 16 + fq * 4 + j]; }
#pragma unroll
    for (int et = 0; et < 16; ++et)
#pragma unroll
        for (int j = 0; j < 4; ++j) acc[et][j] *= w0r[j];
#pragma unroll
    for (int ks = 0; ks < 4; ++ks) if (ks < nks) {
        const bf16x8 pf = *(const bf16x8*)&sP[(wave * 16 + fr) * 136 + ks * 32 + fq * 8];
#pragma unroll
        for (int eg = 0; eg < 16; eg += 8) { bf16x8 vf[8];
#pragma unroll
            for (int k = 0; k < 8; ++k) vf[k] = *(const bf16x8*)&sVt[((eg + k) * 16 + fr) * 136 + ks * 32 + fq * 8];
            PIN8(vf);
#pragma unroll
            for (int k = 0; k < 8; ++k) acc[eg + k] = mfma16(pf, vf[k], acc[eg + k]); }
    }
    uint2 og[16], zg[16];
#pragma unroll
    for (int r = 0; r < 16; ++r) { const size_t row = (size_t)(rb + wave * 16 + r);
        og[r] = *(const uint2*)(c.H + row * NH + HO + h * 256 + lane * 4); zg[r] = *(const uint2*)(c.H + row * NH + HZ + h * 256 + lane * 4); }
    __syncthreads();
    float* hb = (float*)lds;
#pragma unroll
    for (int et = 0; et < 16; ++et)
#pragma unroll
        for (int j = 0; j < 4; ++j) hb[(wave * 16 + fq * 4 + j) * 260 + et * 16 + fr] = acc[et][j] * rinv[j];
    __syncthreads();
    { const float4 g4 = *(const float4*)(c.mng + l * 1024 + h * 256 + lane * 4);
#pragma unroll
      for (int r = 0; r < 16; ++r) {
        const int t = wave * 16 + r; const size_t row = (size_t)(rb + t);
        const float4 hv = *(const float4*)(hb + t * 260 + lane * 4);
        const float mu = wave_sum(hv.x + hv.y + hv.z + hv.w) * (1.f / 256.f);
        const float d0 = hv.x - mu, d1 = hv.y - mu, d2 = hv.z - mu, d3 = hv.w - mu;
        const float rs = rsqrtf(wave_sum(d0 * d0 + d1 * d1 + d2 * d2 + d3 * d3) * (1.f / 256.f) + LN_EPS);
        const uint2 o2 = og[r], z2 = zg[r];
        const float o0 = bf2f((u16)(o2.x & 0xffff)), o1 = bf2f((u16)(o2.x >> 16)), o2f = bf2f((u16)(o2.y & 0xffff)), o3 = bf2f((u16)(o2.y >> 16));
        const float z0 = bf2f((u16)(z2.x & 0xffff)), z1 = bf2f((u16)(z2.x >> 16)), z2f = bf2f((u16)(z2.y & 0xffff)), z3 = bf2f((u16)(z2.y >> 16));
        uint2 ov;
        ov.x = pack2(d0 * rs * g4.x * sigm(o0) * silu(z0), d1 * rs * g4.y * sigm(o1) * silu(z1));
        ov.y = pack2(d2 * rs * g4.z * sigm(o2f) * silu(z2f), d3 * rs * g4.w * sigm(o3) * silu(z3));
        *(uint2*)(c.XB + row * D + h * 256 + lane * 4) = ov;
      } }
    __syncthreads();
}

DI void swa_item(const Ctx& c, const int l, const int item, unsigned char* lds) {
    u16* sVt = (u16*)lds;
    u16* sPw = (u16*)(lds + 35840);
    const int tid = otid(), lane = tid & 63, wave = __builtin_amdgcn_readfirstlane(tid >> 6), fr = lane & 15, fq = lane >> 4;
    const int b = item >> 7, n = (item >> 2) & 31, kv = (item >> 1) & 1, hp = item & 1;
    const int pbase = (n - 1) * 128;
    { const int jj = tid & 255, dg = tid >> 8; const int p = pbase + jj;
      const u16* vp = c.H + (size_t)(b * 4096 + (p < 0 ? 0 : p)) * NH + HAV + kv * 64 + dg * 32;
#pragma unroll
      for (int i = 0; i < 4; ++i) { bf16x8 vv = *(const bf16x8*)(vp + i * 8);
#pragma unroll
        for (int e = 0; e < 8; ++e) sVt[(dg * 32 + i * 8 + e) * 280 + jj] = (p < 0) ? (u16)0 : (u16)vv[e]; }
      for (int i = tid; i < 64 * 24; i += 512) sVt[(i / 24) * 280 + 256 + (i % 24)] = 0; }
    u16* sP = sPw + wave * 16 * 168;
    const int i0 = wave * 16;
    const size_t qrow = (size_t)(b * 4096 + n * 128 + i0);
    u16* sKw = (u16*)(lds + 78848);
    { const int kr = tid >> 3, kc = (tid & 7) * 8;
      bf16x8 kk[4];
#pragma unroll
      for (int p4 = 0; p4 < 4; ++p4) { const int jj = p4 * 64 + kr; const int p = pbase + jj;
          kk[p4] = *(const bf16x8*)(c.H + (size_t)(b * 4096 + (p < 0 ? 0 : p)) * NH + HAK + kv * 64 + kc); }
#pragma unroll
      for (int p4 = 0; p4 < 4; ++p4) *(bf16x8*)(sKw + (p4 * 64 + kr) * 72 + kc) = kk[p4]; }
    __syncthreads();
    bf16x8 kf0[9], kf1[9];
#pragma unroll
    for (int jt = 0; jt < 9; ++jt) {
        const u16* kp = sKw + (i0 + jt * 16 + fr) * 72 + fq * 8;
        kf0[jt] = *(const bf16x8*)kp; kf1[jt] = *(const bf16x8*)(kp + 32);
    }
    bf16x8 qfa[2][2];
#pragma unroll
    for (int hh = 0; hh < 2; ++hh) { const u16* qp = c.H + (qrow + fr) * NH + HAQ + (kv * 4 + hp * 2 + hh) * 64 + fq * 8; qfa[hh][0] = *(const bf16x8*)qp; qfa[hh][1] = *(const bf16x8*)(qp + 32); }
#pragma unroll
    for (int hh = 0; hh < 2; ++hh) {
    const int hq = kv * 4 + hp * 2 + hh;
    f32x4 sc[9];
#pragma unroll
    for (int jt = 0; jt < 9; ++jt) {
        f32x4 a = (f32x4){0.f, 0.f, 0.f, 0.f};
        a = mfma16(qfa[hh][0], kf0[jt], a); a = mfma16(qfa[hh][1], kf1[jt], a);
        sc[jt] = a;
    }
    const float sink = c.sinks[l * 8 + hq];
    float rmax[4], rsum[4];
#pragma unroll
    for (int j = 0; j < 4; ++j) rmax[j] = -3.0e38f;
#pragma unroll
    for (int jt = 0; jt < 9; ++jt) { const int p = pbase + i0 + jt * 16 + fr;
#pragma unroll
        for (int j = 0; j < 4; ++j) { const int rel = 128 + fq * 4 + j - jt * 16 - fr; const bool ok = (rel >= 0) && (rel <= 128) && (p >= 0);
            const float s = ok ? sc[jt][j] * 0.125f : -3.0e38f; sc[jt][j] = s; rmax[j] = fmaxf(rmax[j], s); } }
#pragma unroll
    for (int j = 0; j < 4; ++j) { float m = rmax[j]; m = fmaxf(m, __shfl_xor(m, 1)); m = fmaxf(m, __shfl_xor(m, 2)); m = fmaxf(m, __shfl_xor(m, 4)); m = fmaxf(m, __shfl_xor(m, 8));
        rmax[j] = fmaxf(m, sink); rsum[j] = 0.f; }
#pragma unroll
    for (int jt = 0; jt < 9; ++jt)
#pragma unroll
        for (int j = 0; j < 4; ++j) { const float e = (sc[jt][j] > -1.0e38f) ? __expf(sc[jt][j] - rmax[j]) : 0.f; sc[jt][j] = e; rsum[j] += e; }
#pragma unroll
    for (int j = 0; j < 4; ++j) { float s = rsum[j]; s += __shfl_xor(s, 1); s += __shfl_xor(s, 2); s += __shfl_xor(s, 4); s += __shfl_xor(s, 8);
        rsum[j] = 1.f / (s + __expf(sink - rmax[j])); }
#pragma unroll
    for (int jt = 0; jt < 9; ++jt)
#pragma unroll
        for (int j = 0; j < 4; ++j) sP[(fq * 4 + j) * 168 + jt * 16 + fr] = f2bf(sc[jt][j] * rsum[j]);
#pragma unroll
    for (int j = 0; j < 4; ++j) sP[(fq * 4 + j) * 168 + 144 + fr] = 0;
    __syncthreads();
    f32x4 oacc[4];
#pragma unroll
    for (int dt = 0; dt < 4; ++dt) oacc[dt] = (f32x4){0.f, 0.f, 0.f, 0.f};
#pragma unroll
    for (int ks = 0; ks < 5; ++ks) { const bf16x8 pf = *(const bf16x8*)&sP[fr * 168 + ks * 32 + fq * 8];
#pragma unroll
        for (int dt = 0; dt < 4; ++dt) { const bf16x8 vf = *(const bf16x8*)&sVt[(dt * 16 + fr) * 280 + i0 + ks * 32 + fq * 8]; oacc[dt] = mfma16(pf, vf, oacc[dt]); } }
#pragma unroll
    for (int dt = 0; dt < 4; ++dt)
#pragma unroll
        for (int j = 0; j < 4; ++j) { const size_t row = qrow + fq * 4 + j; const int d = dt * 16 + fr;
            const float az = bf2f(c.H[row * NH + HAZ + hq * 64 + d]);
            c.XB[row * D + 1536 + hq * 64 + d] = f2bf(oacc[dt][j] * silu(az)); }
    __syncthreads();
    }
}

DI void conv_item(const Ctx& c, const int l, const int item, unsigned char* lds) {
    float* pst = (float*)lds;
    float* st = pst + 512;
    const int tid = otid(), lane = tid & 63, wave = __builtin_amdgcn_readfirstlane(tid >> 6);
    const int b = item >> 7, tl = item & 127, t0 = tl * 32;
    float a[62];
    { const u16* hu = c.H + (size_t)(b * 4096) * NH + HCU + tid; const u16* hg = c.H + (size_t)(b * 4096) * NH + HCG + tid;
#pragma unroll
      for (int r0 = 0; r0 < 62; r0 += 31) {
          u16 uu[31], gg[31];
#pragma unroll
          for (int k = 0; k < 31; ++k) { const int tt = t0 - 30 + r0 + k; const size_t ro = (size_t)(tt < 0 ? 0 : tt) * NH; uu[k] = hu[ro]; gg[k] = hg[ro]; }
#pragma unroll
          for (int k = 0; k < 31; ++k) { const int tt = t0 - 30 + r0 + k; a[r0 + k] = (tt >= 0) ? bf2f(uu[k]) * sigm(bf2f(gg[k])) : 0.f; }
      } }
    if (tl == 127) {
#pragma unroll
        for (int r = 32; r < 62; ++r) c.out[O_CONVP + (size_t)((l * 2 + b) * 30 + (r - 32)) * 512 + tid] = a[r];
    }
    float y[32];
    { float w[31];
#pragma unroll
      for (int j = 0; j < 31; ++j) w[j] = c.conv_w[(l * 31 + j) * 512 + tid];
      const float cb = c.conv_b[l * 512 + tid];
#pragma unroll
      for (int t = 0; t < 32; ++t) { float acc = cb;
#pragma unroll
          for (int j = 0; j < 31; ++j) acc += w[j] * a[t + j];
          y[t] = acc; } }
    u16 czr[32];
#pragma unroll
    for (int t = 0; t < 32; ++t) czr[t] = c.H[(size_t)(b * 4096 + t0 + t) * NH + HCZ + tid];
    float* sy = (float*)(lds + 4096);
#pragma unroll
    for (int t = 0; t < 32; ++t) sy[t * 512 + tid] = y[t];
    __syncthreads();
#pragma unroll
    for (int k = 0; k < 4; ++k) { const int t = wave * 4 + k; float s = 0.f, q = 0.f;
#pragma unroll
        for (int i = 0; i < 8; ++i) { const float v = sy[t * 512 + lane + 64 * i]; s += v; q += v * v; }
        s = wave_sum(s); q = wave_sum(q);
        if (lane == 0) { const float mu = s * (1.f / 512.f); st[t * 2] = mu; st[t * 2 + 1] = rsqrtf(fmaxf(q * (1.f / 512.f) - mu * mu, 0.f) + LN_EPS); } }
    __syncthreads();
    const float lg = c.cln_g[l * 512 + tid], lb = c.cln_b[l * 512 + tid];
#pragma unroll
    for (int t = 0; t < 32; ++t) { const size_t row = (size_t)(b * 4096 + t0 + t);
        const float yn = (y[t] - st[t * 2]) * st[t * 2 + 1] * lg + lb;
        c.XB[row * D + 1024 + tid] = f2bf(silu(yn) * silu(bf2f(czr[t]))); }
    __syncthreads();
}

DI float block_sum512(float v, float* red) {
    v = wave_sum(v);
    __syncthreads();
    if ((threadIdx.x & 63) == 0) red[threadIdx.x >> 6] = v;
    __syncthreads();
    float s = 0.f;
#pragma unroll
    for (int i = 0; i < 8; ++i) s += red[i];
    return s;
}

DI void smlstm_item(const Ctx& c, const int l, const int item, unsigned char* lds) {
    float* sq = (float*)lds; float* sk = sq + 256; float* sv = sq + 512; float* sn = sq + 768; float* red = sq + 1024; float* part = sq + 1040;
    const int tid = otid(), b = item >> 2, h = item & 3;
    const size_t row = (size_t)(TP + b);
    const size_t sidx = (size_t)((l * 32 + b) * 4 + h);
    if (tid < 256) { sq[tid] = bf2f(c.H[row * NH + HQ + h * 256 + tid]); sk[tid] = bf2f(c.H[row * NH + HK + h * 256 + tid]) * 0.0625f;
        sv[tid] = bf2f(c.H[row * NH + HV + h * 256 + tid]); sn[tid] = c.state_n[sidx * 256 + tid]; }
    __syncthreads();
    const float qk = block_sum512(tid < 256 ? sq[tid] * sk[tid] : 0.f, red);
    const float qn = block_sum512(tid < 256 ? sq[tid] * sn[tid] : 0.f, red);
    const float m0 = c.state_m[sidx], ig = c.GIG[row * 4 + h], lf = c.GLF[row * 4 + h];
    const float m = fmaxf(lf + m0, ig);
    const float wg = __expf(ig - m), w0 = __expf(lf + m0 - m);
    const float s = qk * wg;
    const float den = s + w0 * qn;
    const float rinv = 1.f / fmaxf(fabsf(den), __expf(-m));
    if (tid == 0) c.out[O_MS + sidx] = m;
    if (tid < 256) c.out[O_NS + sidx * 256 + tid] = w0 * sn[tid] + wg * sk[tid];
    { const int e4 = (tid & 63) * 4, dg = tid >> 6;
      const float* C0 = c.state_C + sidx * 65536; float* Cn = c.out + O_CS + sidx * 65536;
      const float4 v4 = *(const float4*)(sv + e4);
      float4 acc = make_float4(0.f, 0.f, 0.f, 0.f);
      for (int d0 = 0; d0 < 32; d0 += 16) {
          float4 cc8[16];
#pragma unroll
          for (int k = 0; k < 16; ++k) cc8[k] = *(const float4*)(C0 + (dg * 32 + d0 + k) * 256 + e4);
#pragma unroll
          for (int k = 0; k < 16; ++k) { const int d = dg * 32 + d0 + k; const float4 cc = cc8[k];
              const float qd = sq[d], gk = wg * sk[d];
              acc.x += qd * cc.x; acc.y += qd * cc.y; acc.z += qd * cc.z; acc.w += qd * cc.w;
              float4 o; o.x = w0 * cc.x + gk * v4.x; o.y = w0 * cc.y + gk * v4.y; o.z = w0 * cc.z + gk * v4.z; o.w = w0 * cc.w + gk * v4.w;
              *(float4*)(Cn + d * 256 + e4) = o; }
      }
      *(float4*)(part + dg * 256 + e4) = acc; }
    __syncthreads();
    float hv = 0.f;
    if (tid < 256) { float qc = 0.f;
#pragma unroll
        for (int g = 0; g < 8; ++g) qc += part[g * 256 + tid];
        hv = (s * sv[tid] + w0 * qc) * rinv; }
    const float mu = block_sum512(tid < 256 ? hv : 0.f, red) * (1.f / 256.f);
    const float dl = (tid < 256) ? hv - mu : 0.f;
    const float var = block_sum512(dl * dl, red) * (1.f / 256.f);
    if (tid < 256) { const float hn = dl * rsqrtf(var + LN_EPS) * c.mng[l * 1024 + h * 256 + tid];
        const float o = bf2f(c.H[row * NH + HO + h * 256 + tid]), z = bf2f(c.H[row * NH + HZ + h * 256 + tid]);
        c.XB[row * D + h * 256 + tid] = f2bf(hn * sigm(o) * silu(z)); }
    __syncthreads();
}

DI void sconv_item(const Ctx& c, const int l, const int b, unsigned char* lds) {
    float* red = (float*)lds;
    const int tid = otid(); const size_t row = (size_t)(TP + b);
    const float u = bf2f(c.H[row * NH + HCU + tid]), g = bf2f(c.H[row * NH + HCG + tid]);
    const float a = u * sigm(g);
    const float* buf = c.state_conv + (size_t)(l * 32 + b) * 30 * 512; float* nb = c.out + O_CONVS + (size_t)(l * 32 + b) * 30 * 512;
    float y = c.conv_b[l * 512 + tid] + c.conv_w[(l * 31 + 30) * 512 + tid] * a;
    { float bv[30], wv[30];
#pragma unroll
      for (int j = 0; j < 30; ++j) { bv[j] = buf[j * 512 + tid]; wv[j] = c.conv_w[(l * 31 + j) * 512 + tid]; }
#pragma unroll
      for (int j = 0; j < 30; ++j) { y += wv[j] * bv[j]; if (j > 0) nb[(j - 1) * 512 + tid] = bv[j]; } }
    nb[29 * 512 + tid] = a;
    const float mu = block_sum512(y, red) * (1.f / 512.f);
    const float dl = y - mu;
    const float var = block_sum512(dl * dl, red) * (1.f / 512.f);
    const float yn = dl * rsqrtf(var + LN_EPS) * c.cln_g[l * 512 + tid] + c.cln_b[l * 512 + tid];
    const float cz = bf2f(c.H[row * NH + HCZ + tid]);
    c.XB[row * D + 1024 + tid] = f2bf(silu(yn) * silu(cz));
    __syncthreads();
}

DI void sattn_item(const Ctx& c, const int l, const int b, unsigned char* lds) {
    float* sq = (float*)lds;
    float* sp = sq + 512;
    const int tid = otid(), lane = tid & 63, w = tid >> 6, kv = w >> 2; const size_t row = (size_t)(TP + b);
    const float* ck = c.cache_k + (size_t)(l * 32 + b) * 128 * 128; const float* cv = c.cache_v + (size_t)(l * 32 + b) * 128 * 128;
    const float qd = bf2f(c.H[row * NH + HAQ + w * 64 + lane]);
    const float kn = bf2f(c.H[row * NH + HAK + kv * 64 + lane]), vn = bf2f(c.H[row * NH + HAV + kv * 64 + lane]);
    sq[w * 64 + lane] = qd;
    __syncthreads();
    float s0 = 0.f, s1 = 0.f;
    { const float* k0 = ck + (size_t)lane * 128 + kv * 64; const float* k1 = ck + (size_t)(lane + 64) * 128 + kv * 64;
#pragma unroll
      for (int i = 0; i < 16; ++i) { const float4 a = *(const float4*)(k0 + i * 4), bb = *(const float4*)(k1 + i * 4); const float4 q4 = *(const float4*)(sq + w * 64 + i * 4);
          s0 += a.x * q4.x + a.y * q4.y + a.z * q4.z + a.w * q4.w; s1 += bb.x * q4.x + bb.y * q4.y + bb.z * q4.z + bb.w * q4.w; } }
    const float s2 = wave_sum(qd * kn) * 0.125f;
    s0 *= 0.125f; s1 *= 0.125f;
    const float sink = c.sinks[l * 8 + w];
    const float m = fmaxf(fmaxf(wave_max(fmaxf(s0, s1)), s2), sink);
    const float e0 = __expf(s0 - m), e1 = __expf(s1 - m), e2 = __expf(s2 - m);
    const float inv = 1.f / (wave_sum(e0 + e1) + e2 + __expf(sink - m));
    sp[w * 132 + lane] = e0 * inv; sp[w * 132 + 64 + lane] = e1 * inv;
    __syncthreads();
    float o = e2 * inv * vn;
    for (int j0 = 0; j0 < 128; j0 += 16) { float vv[16];
#pragma unroll
        for (int k = 0; k < 16; ++k) vv[k] = cv[(size_t)(j0 + k) * 128 + kv * 64 + lane];
#pragma unroll
        for (int k = 0; k < 16; ++k) o += sp[w * 132 + j0 + k] * vv[k]; }
    const float az = bf2f(c.H[row * NH + HAZ + w * 64 + lane]);
    c.XB[row * D + 1536 + w * 64 + lane] = f2bf(o * silu(az));
    float* nk = c.out + O_KS + (size_t)(l * 32 + b) * 16384; float* nv = c.out + O_VS + (size_t)(l * 32 + b) * 16384;
    for (int i0 = tid; i0 < 127 * 128; i0 += 512 * 8) { float kk[8], vv[8];
#pragma unroll
        for (int k = 0; k < 8; ++k) { const int i = i0 + k * 512; const int ii = i < 127 * 128 ? i : 0; kk[k] = ck[ii + 128]; vv[k] = cv[ii + 128]; }
#pragma unroll
        for (int k = 0; k < 8; ++k) { const int i = i0 + k * 512; if (i < 127 * 128) { nk[i] = kk[k]; nv[i] = vv[k]; } } }
    if (tid < 128) { nk[127 * 128 + tid] = bf2f(c.H[row * NH + HAK + tid]); nv[127 * 128 + tid] = bf2f(c.H[row * NH + HAV + tid]); }
    __syncthreads();
}

DI void pkv_item(const Ctx& c, const int l, const int b) {
    float* nk = c.out + O_KP + (size_t)(l * 2 + b) * 16384; float* nv = c.out + O_VP + (size_t)(l * 2 + b) * 16384;
    const int t0 = otid();
    for (int i0 = t0; i0 < 16384; i0 += 512 * 8) { u16 kk[8], vv[8];
#pragma unroll
        for (int k = 0; k < 8; ++k) { const int i = i0 + k * 512; const size_t row = (size_t)(b * 4096 + 3968 + (i >> 7)); const int cc = i & 127; kk[k] = c.H[row * NH + HAK + cc]; vv[k] = c.H[row * NH + HAV + cc]; }
#pragma unroll
        for (int k = 0; k < 8; ++k) { const int i = i0 + k * 512; nk[i] = bf2f(kk[k]); nv[i] = bf2f(vv[k]); } }
}

typedef const __attribute__((address_space(4))) Args* KArgs;
DI void make_ctx(Ctx& c) {
#if defined(__HIP_DEVICE_COMPILE__)
    KArgs p = (KArgs)__builtin_amdgcn_kernarg_segment_ptr();
    asm volatile("" : "+s"(p));
    const Args a = *p;
    c.x_prompt = a.in[0]; c.x_sample = a.in[1]; c.state_C = a.in[2]; c.state_n = a.in[3]; c.state_m = a.in[4]; c.state_conv = a.in[5];
    c.cache_k = a.in[6]; c.cache_v = a.in[7]; c.w_in = a.in[8]; c.w_out = a.in[9]; c.b_i = a.in[10]; c.b_f = a.in[11]; c.mng = a.in[12];
    c.conv_w = a.in[13]; c.conv_b = a.in[14]; c.cln_g = a.in[15]; c.cln_b = a.in[16]; c.sinks = a.in[17]; c.ln_g = a.in[18]; c.ln_b = a.in[19];
    c.out = a.out;
    c.XB = (u16*)(a.ws + WS_XB); c.WTI = (u16*)(a.ws + WS_WTI); c.WTO = (u16*)(a.ws + WS_WTO); c.H = (u16*)(a.ws + WS_H); c.CS = (u16*)(a.ws + WS_CSB);
    c.DN = (float*)(a.ws + WS_DN); c.AB = (float*)(a.ws + WS_AB); c.M0 = (float*)(a.ws + WS_M0); c.GIG = (float*)(a.ws + WS_GIG); c.GLF = (float*)(a.ws + WS_GLF);
    c.CS2 = (u16*)(a.ws + WS_CS2); c.N0 = (float*)(a.ws + WS_N0);
    c.STATP = (float*)(a.ws + WS_STATP); c.GPART = (float*)(a.ws + WS_GPART); c.GW = (float*)(a.ws + WS_GW);
    c.PANEL = (unsigned*)(a.ws + WS_BAR + 64); c.SAMP = (unsigned*)(a.ws + WS_BAR + 320);
    c.MCNT = (unsigned*)(a.ws + WS_BAR + 336); c.SCNT = (unsigned*)(a.ws + WS_BAR + 400); c.QCNT = (unsigned*)(a.ws + WS_BAR + 472);
#endif
}

DI void grid_barrier(unsigned* bar, const unsigned target) {
    asm volatile("s_waitcnt vmcnt(0)" ::: "memory");
    __syncthreads();
    if (threadIdx.x == 0) {
        __builtin_amdgcn_fence(__ATOMIC_RELEASE, "agent");
        asm volatile("s_waitcnt vmcnt(0)" ::: "memory");
        (void)__hip_atomic_fetch_add(bar, 1u, __ATOMIC_RELAXED, __HIP_MEMORY_SCOPE_AGENT);
        unsigned sp = 0;
        while (__hip_atomic_load(bar, __ATOMIC_RELAXED, __HIP_MEMORY_SCOPE_AGENT) < target) { __builtin_amdgcn_s_sleep(1); if (++sp > (1u << 24)) break; }
        __builtin_amdgcn_fence(__ATOMIC_ACQUIRE, "agent");
        asm volatile("s_waitcnt vmcnt(0)" ::: "memory");
    }
    __syncthreads();
}
#define GSYNC1() do { ++nsync; grid_barrier((unsigned*)(((KArgs)__builtin_amdgcn_kernarg_segment_ptr())->ws + WS_BAR), nsync * (unsigned)gridDim.x); } while (0)
#define GSYNC() do { GSYNC1(); if (GS2) GSYNC1(); } while (0)


#define PROBE_DUMP(stage, SRC16, NSRC) if (PROBE_STAGE == (stage)) { GSYNC(); Ctx c; make_ctx(c); const int tid = otid(); \
      for (size_t i = (size_t)bid * 512 + tid; i < 38011152; i += (size_t)G * 512) { float v = 0.0f; \
          if (i < O_YS) { const size_t j = i * 4; if (j < (size_t)(NSRC)) v = bf2f((SRC16)[j]); } \
          else if (PROBE_AUX && i < O_CP) { const size_t j = i - O_YS; v = (PROBE_STAGE == 3) ? c.N0[j] : ((j < 32896) ? c.GIG[j] : c.GLF[j - 32896 < 32896 ? j - 32896 : 0]); } \
          else if (PROBE_AUX && i < O_CP + 256) { v = c.M0[i - O_CP]; } else if (PROBE_AUX && i < O_CP + 768) { v = c.AB[i - O_CP - 256]; } \
          c.out[i] = v; } \
      return; }

__global__ void __launch_bounds__(512, 2) mk_fwd(Args a_unused) {
    extern __shared__ __attribute__((aligned(16))) unsigned char lds[];
    cg::grid_group grid = cg::this_grid();
    const int G = gridDim.x, bid = blockIdx.x;
    unsigned nsync = 0;
    if (gridDim.x > 0x3fffffffu) grid.sync();
#if PROBE_POISON
    { Ctx c; make_ctx(c); const int tid = otid();
      for (int i = tid; i < LDS_BYTES / 16; i += 512) ((uint4*)lds)[i] = make_uint4(~0u, ~0u, ~0u, ~0u);
      uint4* w4 = (uint4*)c.XB;
      for (size_t i = (size_t)bid * 512 + tid; i < (size_t)285872640 / 16; i += (size_t)G * 512) if (i < WS_BAR / 16 || i >= WS_CS2 / 16) w4[i] = make_uint4(~0u, ~0u, ~0u, ~0u);
      uint4* o4 = (uint4*)c.out;
      for (size_t i = (size_t)bid * 512 + tid; i < (size_t)38011152 / 4; i += (size_t)G * 512) o4[i] = make_uint4(~0u, ~0u, ~0u, ~0u);
      __syncthreads(); }
    GSYNC();
#endif

    for (int rep = 0; rep < 1 + (REPEAT_MASK & 1); ++rep) { Ctx c; make_ctx(c);
      row_phase<0>(c, 0, 0, lds);
      const int tid = otid();
      for (size_t i = (size_t)bid * 512 + tid; i < (size_t)(MP - TT) * D / 8; i += (size_t)G * 512) ((uint4*)(c.XB + (size_t)TT * D))[i] = make_uint4(0, 0, 0, 0);
      for (int i = bid * 512 + tid; i < 2 * 8 * 2048; i += G * 512) { const int ll = i >> 14, j = (i >> 11) & 7, k = i & 2047; c.GW[i] = c.w_in[(size_t)ll * D * DIN + (size_t)k * DIN + 4096 + j]; }
      for (int it = bid; it < 992; it += G) transpose_item(c.w_in, DIN, 4096, c.WTI, it, 62, lds);
      }
    GSYNC();

    for (int l = 0; l < 2; ++l) {
        if (l == 1) { Ctx c; make_ctx(c); const int tid = otid();
            for (int i = bid * 512 + tid; i < TP * 8; i += G * 512) { const int row = i >> 3, j = i & 7; float sacc = 0.f;
#pragma unroll
                for (int p = 0; p < 8; ++p) sacc += c.GPART[((size_t)row * 8 + p) * 8 + j];
                if (j < 4) c.GIG[row * 4 + j] = sacc + c.b_i[4 + j];
                else { const float z = sacc + c.b_f[4 + (j - 4)]; c.GLF[row * 4 + (j - 4)] = fminf(z, 0.f) - __logf(1.f + __expf(-fabsf(z))); } } }
        for (int rep = 0; rep < 1 + ((REPEAT_MASK >> 1) & 1); ++rep) { Ctx c; make_ctx(c); gemm_phase<0>(c.XB, c.WTI, MP / 256, NH / 256, c, l, lds); }
        GSYNC();
        PROBE_DUMP(1, c.H, (size_t)MP * NH)
        { const int n_items = 962 + (l == 0 ? 992 + 512 : 0);
          for (int it = bid; it < 256; it += G) { Ctx c; make_ctx(c); m1_item(c, it, lds); publish_counter_wt(c.MCNT + l * 8 + (it >> 5)); }
          { Ctx c; make_ctx(c);
            for (int it = bid; it < 256; it += G) { wait_counter_wt(c.MCNT + l * 8 + (it >> 5), 32u); scan_item(c, l, it, lds); publish_counter_wt(c.SCNT + l * 8 + (it >> 5)); } }
          { int it = 256 + bid;
            while (it < n_items) {
              Ctx c; make_ctx(c);
              int nxt = 0;
              if (threadIdx.x == 0) nxt = 256 + G + (int)__hip_atomic_fetch_add(c.QCNT + l, 1u, __ATOMIC_RELAXED, __HIP_MEMORY_SCOPE_AGENT);
              if (it < 512) swa_item(c, l, it - 256, lds);
              else if (it < 768) conv_item(c, l, it - 512, lds);
              else if (it < 896) smlstm_item(c, l, it - 768, lds);
              else if (it < 928) sconv_item(c, l, it - 896, lds);
              else if (it < 960) sattn_item(c, l, it - 928, lds);
              else if (it < 962) pkv_item(c, l, it - 960);
              else if (it < 962 + 992) transpose_item(c.w_in + (size_t)D * DIN, DIN, 4096, c.WTI, it - 962, 62, lds);
              else { const int j = it - (962 + 992), ll = j >> 8; transpose_item(c.w_out + (size_t)ll * D * D, D, 1 << 30, c.WTO + (size_t)ll * D * D, j & 255, 16, lds); }
              volatile int* slot = (volatile int*)(lds + LDS_BYTES - 16);
              __syncthreads();
              if (threadIdx.x == 0) *slot = nxt;
              __syncthreads();
              it = *slot;
            } }
          { Ctx c; make_ctx(c);
            for (int it = bid; it < 256; it += G) { wait_counter_wt(c.SCNT + l * 8 + (it >> 5), 32u); m3_item(c, l, it, lds); } }
        }
        GSYNC();
        { Ctx c; make_ctx(c); gemm_phase<2>(c.XB, c.WTO + (size_t)l * D * D, TP / 256, D / 256, c, l, lds);
          for (int it = bid; it < 32; it += G) gemm2_sample_item(c, c.WTO + (size_t)l * D * D, l, it, lds); }
        if (l == 0) GSYNC();
    }
#if OUT_MASK
    GSYNC();
    { Ctx c; make_ctx(c); const int tid = otid();
      const size_t lo[6] = {O_YP, O_YS, O_CP, O_CONVP, O_CS, O_CONVS}, hi[6] = {O_YS, O_CP, O_CONVP, O_CS, O_CONVS, 38011152};
#pragma unroll
      for (int g = 0; g < 6; ++g) if ((OUT_MASK >> g) & 1)
          for (size_t i = lo[g] + (size_t)bid * 512 + tid; i < hi[g]; i += (size_t)G * 512) c.out[i] = 1.0f; }
#endif
}

extern "C" void kernel_launch(void* const* d_in, const int* in_sizes, int n_in,
                              void* d_out, int out_size, void* d_ws, size_t ws_size,
                              hipStream_t stream) {
    static int grid_blocks = 0;
    if (!grid_blocks) {
        int dev = 0, cus = 0, per_cu = 0;
        (void)hipGetDevice(&dev);
        (void)hipDeviceGetAttribute(&cus, hipDeviceAttributeMultiprocessorCount, dev);
        (void)hipFuncSetAttribute((const void*)mk_fwd, hipFuncAttributeMaxDynamicSharedMemorySize, LDS_BYTES);
        (void)hipOccupancyMaxActiveBlocksPerMultiprocessor(&per_cu, (const void*)mk_fwd, 512, LDS_BYTES);
        grid_blocks = cus > 0 ? cus : 256;
        if (per_cu < 1) fprintf(stderr, "occupancy query says %d blocks/CU\n", per_cu);
    }
    (void)hipMemsetAsync((unsigned char*)d_ws + WS_BAR, 0, 512, stream);
    Args a{};
    for (int i = 0; i < 20; ++i) a.in[i] = (const float*)d_in[i];
    a.out = (float*)d_out; a.ws = (unsigned char*)d_ws;
    void* args[] = {&a};
    hipError_t e = hipLaunchCooperativeKernel((const void*)mk_fwd, dim3(grid_blocks), dim3(512), args, LDS_BYTES, stream);
    if (e != hipSuccess) fprintf(stderr, "cooperative launch failed: %s (grid %d)\n", hipGetErrorString(e), grid_blocks);
}
```
